# Optimizing an MI355X kernel written in HIP

```python
import math
import jax, jax.numpy as jnp
from jax import lax
import numpy as np

D_MODEL = 1024
BATCH = 8
SEQ = 8192
DEPTH = 2

GRID_W = 64
CTX_LEN = 256
BRANCH_W = D_MODEL
GLA_HEADS = 4
GLA_DK = D_MODEL // (2 * GLA_HEADS)
GLA_DV = BRANCH_W // GLA_HEADS
GLA_RANK = 16
GLA_TAU = 16.0
GLA_CHUNK = 64
DIFF_HEADS = 8
DIFF_DH = BRANCH_W // (2 * DIFF_HEADS)
MLA_HEADS = 8
MLA_Q_RANK = 256
MLA_KV_RANK = 128
MLA_NOPE = 128
MLA_ROPE = 64
MLA_DV = BRANCH_W // MLA_HEADS
MLA_SCALE = (MLA_NOPE + MLA_ROPE) ** -0.5
ROPE_DIM = 64
ROPE_BASE = 10000.0
Q_BLOCK = 128
FFN_HIDDEN = ((8 * D_MODEL // 3 + 255) // 256) * 256
DEEPNORM_ALPHA = (2 * DEPTH) ** 0.25
DEEPNORM_BETA = (8 * DEPTH) ** -0.25
EPS = 1e-6
IN_SIZES = (GLA_HEADS * GLA_DK, GLA_HEADS * GLA_DK, BRANCH_W, BRANCH_W, 2 * GLA_RANK,
            2 * DIFF_HEADS * DIFF_DH, 2 * DIFF_HEADS * DIFF_DH, BRANCH_W,
            MLA_Q_RANK, MLA_KV_RANK, MLA_ROPE, 3 * D_MODEL)
N_IN = sum(IN_SIZES)

kernel_name = "hybrid_gla_diff_mla_dit_block"


def layer_norm(x, g=None, b=None):
    xf = x.astype(jnp.float32)
    mu = jnp.mean(xf, axis=-1, keepdims=True)
    var = jnp.mean(jnp.square(xf - mu), axis=-1, keepdims=True)
    y = (xf - mu) * lax.rsqrt(var + EPS)
    if g is not None:
        y = y * g + b
    return y.astype(x.dtype)


def rms_norm(x, g):
    xf = x.astype(jnp.float32)
    y = xf * lax.rsqrt(jnp.mean(jnp.square(xf), axis=-1, keepdims=True) + EPS) * g
    return y.astype(x.dtype)


def modulate(x, shift, scale):
    return layer_norm(x) * (1.0 + scale) + shift


def axial_rope_tables(L, dtype):
    rows = L // GRID_W
    pos_row = jnp.broadcast_to(jnp.arange(rows, dtype=jnp.float32)[:, None], (rows, GRID_W)).reshape(L)
    pos_col = jnp.broadcast_to(jnp.arange(GRID_W, dtype=jnp.float32)[None, :], (rows, GRID_W)).reshape(L)
    d_axis = ROPE_DIM // 2
    inv = ROPE_BASE ** (-jnp.arange(0, d_axis, 2, dtype=jnp.float32) / d_axis)
    ang = jnp.concatenate([pos_row[:, None] * inv, pos_col[:, None] * inv], axis=-1)
    return jnp.cos(ang).astype(dtype), jnp.sin(ang).astype(dtype)


def apply_rope(x, cos, sin):
    half = ROPE_DIM // 2
    x1, x2 = x[..., :half], x[..., half:]
    return jnp.concatenate([x1 * cos - x2 * sin, x1 * sin + x2 * cos], axis=-1)


def split_columns(p):
    offsets = []
    acc = 0
    for size in IN_SIZES[:-1]:
        acc += size
        offsets.append(acc)
    return jnp.split(p, offsets, axis=-1)


def gla_chunked(q, k, v, log_a, s0, inclusive):
    B, H, L, dk = q.shape
    dv = v.shape[-1]
    n = L // GLA_CHUNK

    def chunks(t):
        return jnp.moveaxis(t.reshape(B, H, n, GLA_CHUNK, t.shape[-1]), 2, 0)

    mask = jnp.tril(jnp.ones((GLA_CHUNK, GLA_CHUNK), dtype=bool), k=0 if inclusive else -1)

    def step(s, inp):
        qc, kc, vc, gc = inp
        b = jnp.cumsum(gc, axis=-2)
        b_last = b[:, :, -1:, :]
        o_inter = jnp.einsum('bhcd,bhde->bhce', qc * jnp.exp(b), s)
        rel = jnp.where(mask[:, :, None], b[:, :, :, None, :] - b[:, :, None, :, :], -jnp.inf)
        a = jnp.einsum('bhid,bhjd,bhijd->bhij', qc, kc, jnp.exp(rel))
        o_intra = jnp.einsum('bhij,bhje->bhie', a, vc)
        s_new = jnp.exp(b_last[:, :, 0, :])[..., None] * s + jnp.einsum(
            'bhcd,bhce->bhde', kc * jnp.exp(b_last - b), vc)
        return s_new, o_inter + o_intra

    s_fin, o = lax.scan(step, s0, (chunks(q), chunks(k), chunks(v), chunks(log_a)))
    o = jnp.moveaxis(o, 0, 2).reshape(B, H, L, dv)
    return o.astype(v.dtype), s_fin


def gla_bidir(q, k, v, la_f, la_b, s0_f, s0_b):
    o_f, s_f = gla_chunked(q, k, v, la_f, s0_f, True)
    flip = lambda t: jnp.flip(t, axis=2)
    o_b, s_b = gla_chunked(flip(q), flip(k), flip(v), flip(la_b), s0_b, False)
    return o_f + flip(o_b), s_f, s_b


def diff_core(q, k, v, lam):
    s = jnp.einsum('bhmqd,bhmkd->bhmqk', q, k)
    p = jax.nn.softmax(s.astype(jnp.float32), axis=-1)
    w = p[:, :, 0] - lam * p[:, :, 1]
    return jnp.einsum('bhqk,bhkd->bhqd', w.astype(v.dtype), v)


def mla_core(q_nope, q_rope, k_nope, k_rope, v):
    s = jnp.einsum('bhqd,bhkd->bhqk', q_nope, k_nope) + jnp.einsum('bhqd,bkd->bhqk', q_rope, k_rope)
    p = jax.nn.softmax(s.astype(jnp.float32), axis=-1)
    return jnp.einsum('bhqk,bhkd->bhqd', p.astype(v.dtype), v)


def to_blocks(t):
    nb = t.shape[-2] // Q_BLOCK
    t = t.reshape(t.shape[:-2] + (nb, Q_BLOCK, t.shape[-1]))
    return jnp.moveaxis(t, -3, 0)


def from_blocks(o):
    o = jnp.moveaxis(o, 0, -3)
    return o.reshape(o.shape[:-3] + (-1, o.shape[-1]))


def sweep_query_blocks(core, qs):
    return from_blocks(lax.map(lambda qb: core(*qb), tuple(to_blocks(q) for q in qs)))


def merge_heads(o):
    B, H, L, d = o.shape
    return o.transpose(0, 2, 1, 3).reshape(B, L, H * d)


def mixer_features(h, rope, w_in, gla_w_a2, gla_b_a, mla_q_norm_g, mla_kv_norm_g, mla_w_uq, mla_w_ukv):
    B, L, _ = h.shape
    gq, gk, gv, gr, ga, dq, dk, dv, mq, mkv, mkr, gates = split_columns(h @ w_in)
    heads = lambda t, n: t.reshape(B, L, n, -1).transpose(0, 2, 1, 3)
    ga = ga.reshape(B, L, 2, GLA_RANK).astype(jnp.float32)
    log_a = jax.nn.log_sigmoid(jnp.einsum('blnr,nre->nble', ga, gla_w_a2)
                               + gla_b_a[:, None, None, :]) / GLA_TAU
    g_q = heads(gq, GLA_HEADS) * GLA_DK ** -0.5
    g_k = heads(gk, GLA_HEADS)
    g_v = heads(gv, GLA_HEADS)
    la_f = heads(log_a[0], GLA_HEADS)
    la_b = heads(log_a[1], GLA_HEADS)
    d_q = dq.reshape(B, L, DIFF_HEADS, 2, DIFF_DH).transpose(0, 2, 3, 1, 4) * DIFF_DH ** -0.5
    d_k = dk.reshape(B, L, DIFF_HEADS, 2, DIFF_DH).transpose(0, 2, 3, 1, 4)
    d_v = heads(dv, DIFF_HEADS)
    q_full = heads(rms_norm(mq, mla_q_norm_g) @ mla_w_uq, MLA_HEADS)
    q_nope, q_rope = q_full[..., :MLA_NOPE], q_full[..., MLA_NOPE:]
    kv = heads(rms_norm(mkv, mla_kv_norm_g) @ mla_w_ukv, MLA_HEADS)
    k_nope, m_v = kv[..., :MLA_NOPE], kv[..., MLA_NOPE:]
    k_rope = mkr
    if rope is not None:
        cos, sin = rope
        d_q = apply_rope(d_q, cos, sin)
        d_k = apply_rope(d_k, cos, sin)
        q_rope = apply_rope(q_rope, cos, sin)
        k_rope = apply_rope(k_rope, cos, sin)
    gla = (g_q, g_k, g_v, la_f, la_b, gr)
    diff = (d_q, d_k, d_v)
    mla = (q_nope * MLA_SCALE, q_rope * MLA_SCALE, k_nope, k_rope, m_v)
    return gla, diff, mla, gates


def merge_branches(o_gla, r, o_diff, o_mla, gates, lam_init, gla_norm_g, diff_norm_g, w_branch, w_out):
    y_a = merge_heads(rms_norm(o_gla, gla_norm_g)) * jax.nn.silu(r)
    y_b = merge_heads(rms_norm(o_diff, diff_norm_g) * (1.0 - lam_init))
    y_c = merge_heads(o_mla)
    g_a, g_b, g_c = jnp.split(gates, 3, axis=-1)
    y = (jax.nn.sigmoid(g_a) * (y_a @ w_branch[0]) + jax.nn.sigmoid(g_b) * (y_b @ w_branch[1])
         + jax.nn.sigmoid(g_c) * (y_c @ w_branch[2]))
    return y @ w_out


def token_mixer(h, hc, rope, lam, lam_init, w_in, gla_w_a2, gla_b_a, gla_norm_g, diff_norm_g,
                mla_q_norm_g, mla_kv_norm_g, mla_w_uq, mla_w_ukv, w_branch, w_out, ctx_out):
    feat_args = (w_in, gla_w_a2, gla_b_a, mla_q_norm_g, mla_kv_norm_g, mla_w_uq, mla_w_ukv)
    lat_gla, lat_diff, lat_mla, lat_gates = mixer_features(h, rope, *feat_args)
    ctx_gla, ctx_diff, ctx_mla, ctx_gates = mixer_features(hc, None, *feat_args)
    B = h.shape[0]
    s0 = jnp.zeros((B, GLA_HEADS, GLA_DK, GLA_DV), jnp.float32)
    o_gc, s_f, s_b = gla_bidir(*ctx_gla[:5], s0, s0)
    o_g, _, _ = gla_bidir(*lat_gla[:5], s_f, s_b)
    dq, dk, dv = lat_diff
    cq, ck, cv = ctx_diff
    dk_all = jnp.concatenate([dk, ck], axis=3)
    dv_all = jnp.concatenate([dv, cv], axis=2)
    o_d = sweep_query_blocks(lambda q: diff_core(q, dk_all, dv_all, lam), (dq,))
    qn, qr, kn, kr, mv = lat_mla
    cqn, cqr, ckn, ckr, cmv = ctx_mla
    kn_all = jnp.concatenate([kn, ckn], axis=2)
    kr_all = jnp.concatenate([kr, ckr], axis=1)
    mv_all = jnp.concatenate([mv, cmv], axis=2)
    o_m = sweep_query_blocks(lambda a, b: mla_core(a, b, kn_all, kr_all, mv_all), (qn, qr))
    merge_args = (lam_init, gla_norm_g, diff_norm_g, w_branch, w_out)
    y = merge_branches(o_g, lat_gla[5], o_d, o_m, lat_gates, *merge_args)
    if not ctx_out:
        return y, None
    o_dc = diff_core(cq, ck, cv, lam)
    o_mc = mla_core(cqn, cqr, ckn, ckr, cmv)
    yc = merge_branches(o_gc, ctx_gla[5], o_dc, o_mc, ctx_gates, *merge_args)
    return y, yc


def swiglu(h, w_in, w_out):
    gate, up = jnp.split(h @ w_in, 2, axis=-1)
    return (jax.nn.silu(gate) * up) @ w_out


def setup_inputs(seed: int = 0) -> dict:
    key = jax.random.key(seed)
    ks = jax.random.split(key, 24)
    D, L = D_MODEL, DEPTH

    def nrm(k, shape, scale):
        return jax.random.normal(k, shape, jnp.float32) * scale

    def gain(k, shape):
        return 1.0 + nrm(k, shape, 0.02)

    return {
        "x": nrm(ks[0], (BATCH, SEQ, D), 1.0),
        "c": nrm(ks[1], (BATCH, D), 1.0),
        "ctx": nrm(ks[2], (BATCH, CTX_LEN, D), 1.0),
        "c_ctx": nrm(ks[3], (D,), 1.0),
        "w_mod": nrm(ks[4], (L, D, 6 * D), D ** -0.5),
        "b_mod": nrm(ks[5], (L, 6 * D), 0.02),
        "w_in": nrm(ks[6], (L, D, N_IN), D ** -0.5),
        "gla_w_a2": nrm(ks[7], (L, 2, GLA_RANK, GLA_HEADS * GLA_DK), GLA_RANK ** -0.5),
        "gla_b_a": nrm(ks[8], (L, 2, GLA_HEADS * GLA_DK), 0.02),
        "gla_norm_g": gain(ks[9], (L, GLA_DV)),
        "diff_lam": nrm(ks[10], (L, 4, DIFF_DH), 0.1),
        "diff_norm_g": gain(ks[11], (L, 2 * DIFF_DH)),
        "mla_q_norm_g": gain(ks[12], (L, MLA_Q_RANK)),
        "mla_kv_norm_g": gain(ks[13], (L, MLA_KV_RANK)),
        "mla_w_uq": nrm(ks[14], (L, MLA_Q_RANK, MLA_HEADS * (MLA_NOPE + MLA_ROPE)), MLA_Q_RANK ** -0.5),
        "mla_w_ukv": nrm(ks[15], (L, MLA_KV_RANK, MLA_HEADS * (MLA_NOPE + MLA_DV)), MLA_KV_RANK ** -0.5),
        "w_branch": nrm(ks[16], (L, 3, BRANCH_W, D), BRANCH_W ** -0.5),
        "w_out": nrm(ks[17], (L, D, D), D ** -0.5 * DEEPNORM_BETA),
        "ln1_g": gain(ks[18], (L, D)),
        "ln1_b": nrm(ks[19], (L, D), 0.02),
        "ffn_w_in": nrm(ks[20], (L, D, 2 * FFN_HIDDEN), D ** -0.5),
        "ffn_w_out": nrm(ks[21], (L, FFN_HIDDEN, D), FFN_HIDDEN ** -0.5 * DEEPNORM_BETA),
        "ln2_g": gain(ks[22], (L, D)),
        "ln2_b": nrm(ks[23], (L, D), 0.02),
    }


def reference(x, c, ctx, c_ctx, w_mod, b_mod, w_in, gla_w_a2, gla_b_a, gla_norm_g, diff_lam,
              diff_norm_g, mla_q_norm_g, mla_kv_norm_g, mla_w_uq, mla_w_ukv, w_branch, w_out,
              ln1_g, ln1_b, ffn_w_in, ffn_w_out, ln2_g, ln2_b):
    rope = axial_rope_tables(x.shape[1], x.dtype)
    c_act = jax.nn.silu(c)
    cc_act = jax.nn.silu(c_ctx)
    xc = ctx
    for l in range(DEPTH):
        last = l == DEPTH - 1
        sh1, sc1, g1, sh2, sc2, g2 = jnp.split((c_act @ w_mod[l] + b_mod[l])[:, None, :], 6, axis=-1)
        csh1, csc1, cg1, csh2, csc2, cg2 = jnp.split(cc_act @ w_mod[l] + b_mod[l], 6, axis=-1)
        lam_init = 0.8 - 0.6 * math.exp(-0.3 * l)
        dl = diff_lam[l].astype(jnp.float32)
        lam = jnp.exp(jnp.sum(dl[0] * dl[1])) - jnp.exp(jnp.sum(dl[2] * dl[3])) + lam_init
        y, yc = token_mixer(modulate(x, sh1, sc1), modulate(xc, csh1, csc1), rope, lam, lam_init,
                            w_in[l], gla_w_a2[l], gla_b_a[l], gla_norm_g[l], diff_norm_g[l],
                            mla_q_norm_g[l], mla_kv_norm_g[l], mla_w_uq[l], mla_w_ukv[l],
                            w_branch[l], w_out[l], not last)
        x = layer_norm(DEEPNORM_ALPHA * x + g1 * y, ln1_g[l], ln1_b[l])
        x = layer_norm(DEEPNORM_ALPHA * x + g2 * swiglu(modulate(x, sh2, sc2), ffn_w_in[l], ffn_w_out[l]),
                       ln2_g[l], ln2_b[l])
        if not last:
            xc = layer_norm(DEEPNORM_ALPHA * xc + cg1 * yc, ln1_g[l], ln1_b[l])
            xc = layer_norm(DEEPNORM_ALPHA * xc + cg2 * swiglu(modulate(xc, csh2, csc2), ffn_w_in[l], ffn_w_out[l]),
                            ln2_g[l], ln2_b[l])
    return x
```

```cpp
#include <hip/hip_runtime.h>
#include <hip/hip_bf16.h>
#include <hip/hip_cooperative_groups.h>
#include <cstdio>
#include <cstdint>
namespace cg = cooperative_groups;

#define DEVI __device__ __forceinline__
typedef unsigned short u16;
typedef __attribute__((ext_vector_type(8))) short bf16x8;
typedef __attribute__((ext_vector_type(4))) short s16x4;
typedef __attribute__((ext_vector_type(16))) float f32x16;
typedef __attribute__((ext_vector_type(4))) float f32x4;
typedef __attribute__((ext_vector_type(4))) unsigned u32x4;
typedef __attribute__((ext_vector_type(2))) unsigned u32x2;

constexpr int DM = 1024, NBATCH = 8, SEQ = 8192, CTXL = 256, ROWS = SEQ + CTXL;
constexpr int NF = 9728;
constexpr int F_GQ = 0, F_GK = 512, F_GV = 1024, F_GR = 2048, F_DQ = 3072, F_DK = 4096, F_DV = 5120, F_MQ = 6144, F_MKV = 6400,
              F_GATE = 6528, F_KR = 9600, F_GA = 9664;
constexpr int FH = 2816;
constexpr int NIN_ORIG = 9696;
constexpr float ALPHA = 1.4142135623730951f;
constexpr float EPS = 1e-6f;
constexpr int NTHREADS = 512;
constexpr int NBP = 2, RP = NBP * ROWS, NPASS = NBATCH / NBP;

constexpr size_t al256(size_t x) { return (x + 255) / 256 * 256; }
constexpr size_t OFF_WIN  = 0;
constexpr size_t OFF_WUQ  = OFF_WIN  + al256((size_t)2 * NF * 1024 * 2);
constexpr size_t OFF_WUKV = OFF_WUQ  + al256((size_t)2 * 1536 * 256 * 2);
constexpr size_t OFF_WBR  = OFF_WUKV + al256((size_t)2 * 2048 * 128 * 2);
constexpr size_t OFF_WOUT = OFF_WBR  + al256((size_t)2 * 3 * 1024 * 1024 * 2);
constexpr size_t OFF_WF1  = OFF_WOUT + al256((size_t)2 * 1024 * 1024 * 2);
constexpr size_t OFF_WF2  = OFF_WF1  + al256((size_t)2 * 5632 * 1024 * 2);
constexpr size_t OFF_MODV = OFF_WF2  + al256((size_t)2 * 1024 * 2816 * 2);
constexpr size_t OFF_ROPE = OFF_MODV + al256((size_t)2 * 9 * 6144 * 4);
constexpr size_t OFF_CTR  = OFF_ROPE + al256((size_t)SEQ * 64 * 4);
constexpr size_t OFF_XC   = OFF_CTR  + 2048;
constexpr size_t OFF_H    = OFF_XC   + al256((size_t)NBP * CTXL * 1024 * 4);
constexpr size_t OFF_FEAT = OFF_H    + al256((size_t)RP * 1024 * 2);
constexpr size_t OFF_QM   = OFF_FEAT + al256((size_t)RP * NF * 2);
constexpr size_t OFF_KV   = OFF_QM   + al256((size_t)RP * 1536 * 2);
constexpr size_t OFF_OG   = OFF_KV   + al256((size_t)RP * 2048 * 2);
constexpr size_t OFF_OD   = OFF_OG   + al256((size_t)2 * RP * 1024 * 2);
constexpr size_t OFF_YC   = OFF_OD   + al256((size_t)2 * RP * 1024 * 2);
constexpr size_t WS_END   = OFF_YC   + al256((size_t)RP * 1024 * 2);
constexpr size_t OFF_YA   = OFF_OG;
constexpr size_t OFF_YB   = OFF_OD;
constexpr size_t OFF_Y    = OFF_H;
constexpr size_t OFF_HID  = OFF_FEAT;

constexpr int LDS_BYTES = 140 * 1024;

struct Params {
  const float *x, *c, *ctx, *c_ctx, *w_mod, *b_mod, *w_in, *gla_w_a2, *gla_b_a, *gla_norm_g, *diff_lam, *diff_norm_g,
      *mla_q_norm_g, *mla_kv_norm_g, *mla_w_uq, *mla_w_ukv, *w_branch, *w_out, *ln1_g, *ln1_b, *ffn_w_in, *ffn_w_out, *ln2_g, *ln2_b;
  float* out;
  char* ws;
};

typedef float f32x2_t __attribute__((ext_vector_type(2)));
typedef __bf16 bf16x2_t __attribute__((ext_vector_type(2)));
DEVI unsigned cvtpk(float lo, float hi) { f32x2_t v = {lo, hi}; bf16x2_t b = __builtin_convertvector(v, bf16x2_t); return __builtin_bit_cast(unsigned, b); }
DEVI u16 f2bf(float f) { return (u16)(cvtpk(f, 0.f) & 0xffffu); }
DEVI float bf2f(u16 h) { return __uint_as_float(((unsigned)h) << 16); }
DEVI float bflo(unsigned w) { return __uint_as_float(w << 16); }
DEVI float bfhi(unsigned w) { return __uint_as_float(w & 0xffff0000u); }
DEVI void st4bf(u16* p, float a, float b, float c, float d) { u32x2 w = {cvtpk(a, b), cvtpk(c, d)}; *(u32x2*)p = w; }
DEVI float wave_sum(float v) {
#pragma unroll
  for (int m = 32; m >= 1; m >>= 1) v += __shfl_xor(v, m);
  return v;
}
DEVI float siluf(float x) { return x / (1.f + expf(-x)); }
DEVI float sigmf(float x) { return 1.f / (1.f + expf(-x)); }
DEVI int crow(int r, int hi) { return (r & 3) + 8 * (r >> 2) + 4 * hi; }
#define SBAR() __builtin_amdgcn_sched_barrier(0)

DEVI int vblock() { return (int)(blockIdx.x & 7) * (int)(gridDim.x >> 3) + (int)(blockIdx.x >> 3); }
DEVI void tile_map(int t, int NTM, int NTN, int& tm, int& tn) {
  const int per = NTM * 4, g = t / per, r = t - g * per;
  const int w = (NTN - g * 4) < 4 ? (NTN - g * 4) : 4;
  tm = r / w; tn = g * 4 + (r - tm * w);
}
DEVI int otid() { int t = threadIdx.x; asm volatile("" : "+v"(t)); return t; }

template <int MI, int NC>
DEVI void mfma_tile(f32x16 (&acc)[2 * NC][MI], const char* Ab, const char* Bb, int rowa0, int rowb0, int sa, int sb, int hi) {
  if constexpr (MI * NC >= 4) {
#pragma unroll
    for (int k16 = 0; k16 < 4; ++k16) {
      const int chn = k16 * 2 + hi;
      bf16x8 ga[2 * NC], gb[MI];
#pragma unroll
      for (int ni = 0; ni < 2 * NC; ++ni) ga[ni] = *(const bf16x8*)(Bb + (rowa0 + 32 * ni) * 128 + ((chn ^ sa) << 4));
#pragma unroll
      for (int mi = 0; mi < MI; ++mi) gb[mi] = *(const bf16x8*)(Ab + (rowb0 + 32 * mi) * 128 + ((chn ^ sb) << 4));
#pragma unroll
      for (int ni = 0; ni < 2 * NC; ++ni)
#pragma unroll
        for (int mi = 0; mi < MI; ++mi)
          acc[ni][mi] = __builtin_amdgcn_mfma_f32_32x32x16_bf16(ga[ni], gb[mi], acc[ni][mi], 0, 0, 0);
    }
    return;
  }
  bf16x8 fa[2][2 * NC], fb[2][MI];
#pragma unroll
  for (int ni = 0; ni < 2 * NC; ++ni) fa[0][ni] = *(const bf16x8*)(Bb + (rowa0 + 32 * ni) * 128 + ((hi ^ sa) << 4));
#pragma unroll
  for (int mi = 0; mi < MI; ++mi) fb[0][mi] = *(const bf16x8*)(Ab + (rowb0 + 32 * mi) * 128 + ((hi ^ sb) << 4));
#pragma unroll
  for (int k16 = 0; k16 < 4; ++k16) {
    if (k16 < 3) {
      const int chn = (k16 + 1) * 2 + hi;
#pragma unroll
      for (int ni = 0; ni < 2 * NC; ++ni) fa[(k16 + 1) & 1][ni] = *(const bf16x8*)(Bb + (rowa0 + 32 * ni) * 128 + ((chn ^ sa) << 4));
#pragma unroll
      for (int mi = 0; mi < MI; ++mi) fb[(k16 + 1) & 1][mi] = *(const bf16x8*)(Ab + (rowb0 + 32 * mi) * 128 + ((chn ^ sb) << 4));
    }
    SBAR();
#pragma unroll
    for (int ni = 0; ni < 2 * NC; ++ni)
#pragma unroll
      for (int mi = 0; mi < MI; ++mi)
        acc[ni][mi] = __builtin_amdgcn_mfma_f32_32x32x16_bf16(fa[k16 & 1][ni], fb[k16 & 1][mi], acc[ni][mi], 0, 0, 0);
    SBAR();
  }
}

template <int MI, int NC>
DEVI void gemm_kloop(f32x16 (&acc)[2 * NC][MI], const u16* __restrict__ A, long lda, const u16* __restrict__ Bt, long ldb, int K, char* lds) {
  const int tid = otid(), wid = tid >> 6, lane = tid & 63, r32 = lane & 31, hi = lane >> 5;
  const int wm = wid & 3, wn = wid >> 2;
  constexpr int ABUF = 32768, BBUF = 16384 * NC;
  char* As = lds; char* Bs = lds + 65536;
  const int ch = tid & 7, rw = tid >> 3;
  const int swz = ((ch ^ ((rw >> 1) & 7)) << 4);
  u32x4 ra[2 * MI], rb[2 * NC];
  const u16* Ap = A + (long)rw * lda + ch * 8;
  const u16* Bp = Bt + (long)rw * ldb + ch * 8;
#define GLOAD(k0) do { _Pragma("unroll") for (int i_ = 0; i_ < 2 * MI; ++i_) ra[i_] = *(const u32x4*)(Ap + (long)(64 * i_) * lda + (k0)); \
    _Pragma("unroll") for (int i_ = 0; i_ < 2 * NC; ++i_) rb[i_] = *(const u32x4*)(Bp + (long)(64 * i_) * ldb + (k0)); } while (0)
#define GWRITE(buf) do { char* a_ = As + (buf) * ABUF + rw * 128 + swz; char* b_ = Bs + (buf) * BBUF + rw * 128 + swz; \
    _Pragma("unroll") for (int i_ = 0; i_ < 2 * MI; ++i_) *(u32x4*)(a_ + i_ * 64 * 128) = ra[i_]; \
    _Pragma("unroll") for (int i_ = 0; i_ < 2 * NC; ++i_) *(u32x4*)(b_ + i_ * 64 * 128) = rb[i_]; } while (0)
#pragma unroll
  for (int i = 0; i < 2 * NC; ++i)
#pragma unroll
    for (int j = 0; j < MI; ++j)
#pragma unroll
      for (int r = 0; r < 16; ++r) acc[i][j][r] = 0.f;
  const int KT = K >> 6;
  const int grp = __builtin_amdgcn_readfirstlane(wid) >> 2;
  const int rowa0 = wn * (64 * NC) + r32, rowb0 = wm * (32 * MI) + r32;
  const int sa = (rowa0 >> 1) & 7, sb = (rowb0 >> 1) & 7;
#define MFMA_ALL(kt_) mfma_tile<MI, NC>(acc, As + ((kt_) & 1) * ABUF, Bs + ((kt_) & 1) * BBUF, rowa0, rowb0, sa, sb, hi)
#define KBAR() do { asm volatile("s_waitcnt lgkmcnt(0)" ::: "memory"); __builtin_amdgcn_s_barrier(); asm volatile("" ::: "memory"); } while (0)
  GLOAD(0); GWRITE(0); SBAR();
  if (KT > 1) GLOAD(64);
  KBAR();
  if (grp == 0) {
    for (int kt = 0; kt < KT; ++kt) {
      MFMA_ALL(kt);
      KBAR();
      if (kt + 1 < KT) { GWRITE((kt + 1) & 1); if (kt + 2 < KT) GLOAD((kt + 2) * 64); }
      KBAR();
    }
  } else {
    for (int kt = 0; kt < KT; ++kt) {
      if (kt + 1 < KT) { GWRITE((kt + 1) & 1); if (kt + 2 < KT) GLOAD((kt + 2) * 64); }
      KBAR();
      MFMA_ALL(kt);
      KBAR();
    }
  }
#undef KBAR
#undef MFMA_ALL
#undef GLOAD
#undef GWRITE
}

DEVI int map_col(int mode, int n) {
  if (mode == 0) return n;
  if (mode == 1) {
    if (n < 3072) return n;
    if (n < 6528) return n + 32;
    if (n < 9600) return n + 96;
    if (n < 9664) return 6560 + (n - 9600);
    if (n < 9696) return 3072 + (n - 9664);
    return -1;
  }
  const int grp = n >> 6, w = n & 63;
  return (w < 32) ? (grp * 32 + w) : (FH + grp * 32 + (w - 32));
}
DEVI void conv_weight(const float* __restrict__ src, int ldsrc, u16* __restrict__ dst, int Ndst, int K, int mode, const float* __restrict__ kscale, char* lds) {
  float* t = (float*)lds;
  const int tid = otid();
  const int ntn = Ndst >> 6, ntk = K >> 6;
  for (int tile = blockIdx.x; tile < ntn * ntk; tile += gridDim.x) {
    const int n0 = (tile / ntk) << 6, k0 = (tile % ntk) << 6;
    __syncthreads();
#pragma unroll
    for (int it = 0; it < 2; ++it) {
      const int idx = tid + it * NTHREADS, kk = idx >> 4, n4 = (idx & 15) * 4;
      const int sc = map_col(mode, n0 + n4);
      f32x4 v = {0.f, 0.f, 0.f, 0.f};
      if (sc >= 0) v = *(const f32x4*)(src + (long)(k0 + kk) * ldsrc + sc);
      if (kscale) { const float ks = kscale[k0 + kk]; v[0] *= ks; v[1] *= ks; v[2] *= ks; v[3] *= ks; }
      t[(n4 + 0) * 68 + kk] = v[0]; t[(n4 + 1) * 68 + kk] = v[1]; t[(n4 + 2) * 68 + kk] = v[2]; t[(n4 + 3) * 68 + kk] = v[3];
    }
    __syncthreads();
    {
      const int nn = tid >> 3, k8 = (tid & 7) * 8;
      const f32x4 a = *(const f32x4*)(t + nn * 68 + k8), c = *(const f32x4*)(t + nn * 68 + k8 + 4);
      u32x4 w = {cvtpk(a[0], a[1]), cvtpk(a[2], a[3]), cvtpk(c[0], c[1]), cvtpk(c[2], c[3])};
      *(u32x4*)(dst + (long)(n0 + nn) * K + k0 + k8) = w;
    }
  }
  __syncthreads();
}

DEVI void phase_modv(const Params& p, char* lds) {
  float* ca = (float*)lds;
  float* red = ca + 9 * 1024;
  float* modv = (float*)(p.ws + OFF_MODV);
  const int tid = otid();
  __syncthreads();
  for (int i = tid; i < 9 * 1024; i += NTHREADS) {
    const float v = (i < 8192) ? p.c[i] : p.c_ctx[i - 8192];
    ca[i] = siluf(v);
  }
  __syncthreads();
  const int col = tid & 63, ks = tid >> 6;
  for (int tile = blockIdx.x; tile < 2 * 96; tile += gridDim.x) {
    const int l = tile / 96, n0 = (tile % 96) * 64;
    const float* W = p.w_mod + (long)l * 1024 * 6144 + n0 + col;
    float a[9];
#pragma unroll
    for (int j = 0; j < 9; ++j) a[j] = 0.f;
    for (int k = ks * 128; k < ks * 128 + 128; ++k) {
      const float w = W[(long)k * 6144];
#pragma unroll
      for (int j = 0; j < 9; ++j) a[j] += ca[j * 1024 + k] * w;
    }
#pragma unroll
    for (int j = 0; j < 9; ++j) red[(ks * 64 + col) * 9 + j] = a[j];
    __syncthreads();
    for (int i = tid; i < 64 * 9; i += NTHREADS) {
      const int cc = i / 9, j = i % 9;
      float s = 0.f;
      for (int q = 0; q < 8; ++q) s += red[(q * 64 + cc) * 9 + j];
      modv[((long)l * 9 + j) * 6144 + n0 + cc] = s + p.b_mod[l * 6144 + n0 + cc];
    }
    __syncthreads();
  }
}

DEVI void phase_rope(const Params& p) {
  float* rope = (float*)(p.ws + OFF_ROPE);
  for (int i = blockIdx.x * NTHREADS + otid(); i < SEQ * 32; i += gridDim.x * NTHREADS) {
    const int t = i >> 5, f = i & 31;
    const float inv = powf(10000.f, -(float)(f & 15) / 16.f);
    const float pos = (f < 16) ? (float)(t >> 6) : (float)(t & 63);
    const float ang = pos * inv;
    rope[t * 64 + f] = cosf(ang);
    rope[t * 64 + 32 + f] = sinf(ang);
  }
}

DEVI void ln_stats(const float (&v)[16], float& mu, float& rstd) {
  float s = 0.f;
#pragma unroll
  for (int i = 0; i < 16; ++i) s += v[i];
  mu = wave_sum(s) * (1.f / 1024.f);
  float q = 0.f;
#pragma unroll
  for (int i = 0; i < 16; ++i) { const float d = v[i] - mu; q += d * d; }
  rstd = rsqrtf(wave_sum(q) * (1.f / 1024.f) + EPS);
}
DEVI void rowload(const float* __restrict__ src, float (&v)[16]) {
  const int lane = otid() & 63;
#pragma unroll
  for (int i = 0; i < 4; ++i) {
    const f32x4 t = *(const f32x4*)(src + i * 256 + lane * 4);
    v[i * 4 + 0] = t[0]; v[i * 4 + 1] = t[1]; v[i * 4 + 2] = t[2]; v[i * 4 + 3] = t[3];
  }
}
DEVI void rowproc(float (&v)[16], float* __restrict__ dst, const float* __restrict__ ag, const float* __restrict__ ab,
                  u16* __restrict__ hout, const float* __restrict__ sh, const float* __restrict__ sc) {
  const int lane = otid() & 63;
  float mu, rstd;
  if (ag) {
    ln_stats(v, mu, rstd);
#pragma unroll
    for (int i = 0; i < 4; ++i) {
      const f32x4 g = *(const f32x4*)(ag + i * 256 + lane * 4);
      const f32x4 b = *(const f32x4*)(ab + i * 256 + lane * 4);
      f32x4 o;
#pragma unroll
      for (int j = 0; j < 4; ++j) { v[i * 4 + j] = (v[i * 4 + j] - mu) * rstd * g[j] + b[j]; o[j] = v[i * 4 + j]; }
      *(f32x4*)(dst + i * 256 + lane * 4) = o;
    }
  }
  if (hout) {
    ln_stats(v, mu, rstd);
#pragma unroll
    for (int i = 0; i < 4; ++i) {
      const f32x4 s1 = *(const f32x4*)(sc + i * 256 + lane * 4);
      const f32x4 s0 = *(const f32x4*)(sh + i * 256 + lane * 4);
      float h[4];
#pragma unroll
      for (int j = 0; j < 4; ++j) h[j] = (v[i * 4 + j] - mu) * rstd * (1.f + s1[j]) + s0[j];
      st4bf(hout + i * 256 + lane * 4, h[0], h[1], h[2], h[3]);
    }
  }
}
DEVI int rr_of(int r) { return r >= ROWS ? r - ROWS : r; }
DEVI int bi_of(int r) { return r >= ROWS ? 1 : 0; }
DEVI const float* modvec(const Params& p, int l, int ps, int r, int which) {
  const float* modv = (const float*)(p.ws + OFF_MODV);
  const int j = (rr_of(r) < SEQ) ? (ps * NBP + bi_of(r)) : 8;
  return modv + ((long)l * 9 + j) * 6144 + which * 1024;
}
DEVI const float* inrow(const Params& p, int ps, int r) {
  const int b = ps * NBP + bi_of(r), rr = rr_of(r);
  return (rr < SEQ) ? (p.x + ((long)b * SEQ + rr) * 1024) : (p.ctx + ((long)b * CTXL + (rr - SEQ)) * 1024);
}
DEVI float* xrow(const Params& p, int ps, int r) {
  const int b = ps * NBP + bi_of(r), rr = rr_of(r);
  return (rr < SEQ) ? (p.out + ((long)b * SEQ + rr) * 1024) : ((float*)(p.ws + OFF_XC) + (long)(bi_of(r) * CTXL + rr - SEQ) * 1024);
}
DEVI int row_next(int r, int nw, bool skipctx) { while (r < RP && skipctx && rr_of(r) >= SEQ) r += nw; return r; }
DEVI void row_loop(const Params& p, int ps, int l, int kind) {
  const int gw = blockIdx.x * 8 + (otid() >> 6), nw = gridDim.x * 8;
  const bool skipctx = (kind == 1 && l == 1) || kind == 3;
  u16* Hb = (u16*)(p.ws + OFF_H);
  float v[16], vn[16];
  int r = row_next(gw, nw, skipctx);
  if (r < RP) rowload(kind == 0 ? inrow(p, ps, r) : xrow(p, ps, r), v);
  while (r < RP) {
    const int rn = row_next(r + nw, nw, skipctx);
    if (rn < RP) rowload(kind == 0 ? inrow(p, ps, rn) : xrow(p, ps, rn), vn);
    float* xr = xrow(p, ps, r);
    u16* hrow = Hb + (long)r * 1024;
    if (kind == 0)      rowproc(v, nullptr, nullptr, nullptr, hrow, modvec(p, 0, ps, r, 0), modvec(p, 0, ps, r, 1));
    else if (kind == 1) rowproc(v, xr, p.ln1_g + l * 1024, p.ln1_b + l * 1024, hrow, modvec(p, l, ps, r, 3), modvec(p, l, ps, r, 4));
    else if (kind == 2) rowproc(v, xr, p.ln2_g, p.ln2_b, hrow, modvec(p, 1, ps, r, 0), modvec(p, 1, ps, r, 1));
    else                rowproc(v, xr, p.ln2_g + 1024, p.ln2_b + 1024, nullptr, nullptr, nullptr);
#pragma unroll
    for (int i = 0; i < 16; ++i) v[i] = vn[i];
    r = rn;
  }
}
DEVI void phase_mod1_l0(const Params& p, int ps) { row_loop(p, ps, 0, 0); }
DEVI void phase_rows_a(const Params& p, int ps, int l) { row_loop(p, ps, l, 1); }
DEVI void phase_rows_b(const Params& p, int ps, int l) {
  if (l == 0) row_loop(p, ps, 0, 2);
  else { row_loop(p, ps, 1, 3); if (ps + 1 < NPASS) row_loop(p, ps + 1, 0, 0); }
}
DEVI int tile_m0(int tm, int l, int TR) { const int tpb = (l == 0 ? ROWS : SEQ) / TR; return (tm / tpb) * ROWS + (tm % tpb) * TR; }
DEVI int tile_ntm(int l, int TR) { return NBP * ((l == 0 ? ROWS : SEQ) / TR); }

template <int NCOLS> DEVI void wave_tile_store(const char* wl, u16* gbase, long ld, int lane) {
  constexpr int RS = NCOLS * 2 + 16, CPR = NCOLS / 8, RPI = 64 / CPR;
  const int rsub = lane / CPR, chk = lane % CPR;
  SBAR();
#pragma unroll 4
  for (int it = 0; it < 64 / RPI; ++it) {
    const int row = it * RPI + rsub;
    const u32x4 v = *(const u32x4*)(wl + row * RS + chk * 16);
    *(u32x4*)(gbase + (long)row * ld + chk * 8) = v;
  }
}
DEVI void lds_put4(char* wl, int RS, int row, int col, float a, float b, float c, float d) { u32x2 w = {cvtpk(a, b), cvtpk(c, d)}; *(u32x2*)(wl + row * RS + col * 2) = w; }

DEVI void phase_gemm_in(const Params& p, int l, char* lds) {
  const u16* H = (const u16*)(p.ws + OFF_H);
  const u16* W = (const u16*)(p.ws + OFF_WIN) + (long)l * NF * 1024;
  u16* feat = (u16*)(p.ws + OFF_FEAT);
  const float* rope = (const float*)(p.ws + OFF_ROPE);
  const int lane = otid() & 63, wid = otid() >> 6, r32 = lane & 31, hi = lane >> 5, wm = wid & 3, wn = wid >> 2;
  constexpr int NTN = NF / 256, NTM = RP / 256;
  for (int tile = vblock(); tile < NTN * NTM; tile += gridDim.x) {
    int tm, tn; tile_map(tile, NTM, NTN, tm, tn);
    const int m0 = tm * 256, n0 = tn * 256;
    f32x16 acc[4][2];
    __syncthreads();
    gemm_kloop<2, 2>(acc, H + (long)m0 * 1024, 1024, W + (long)n0 * 1024, 1024, 1024, lds);
    SBAR();
    char* wl = lds + wid * (64 * 272);
#pragma unroll
    for (int cg2 = 0; cg2 < 2; ++cg2) {
      SBAR();
      const int cb = n0 + wn * 128 + cg2 * 64;
      int mode = 0;
      if (cb < F_GK) mode = 1;
      else if ((cb >= F_DQ && cb < F_DV) || cb == F_KR) mode = 2;
      else if (cb >= F_GATE && cb < F_KR) mode = 3;
#pragma unroll
      for (int mi = 0; mi < 2; ++mi) {
        const int m = m0 + wm * 64 + mi * 32 + r32;
#pragma unroll
        for (int q = 0; q < 4; ++q) {
          const int ci = q * 8 + hi * 4;
          float x1[4], x2[4];
#pragma unroll
          for (int j = 0; j < 4; ++j) { x1[j] = acc[2 * cg2][mi][q * 4 + j]; x2[j] = acc[2 * cg2 + 1][mi][q * 4 + j]; }
          if (mode == 1) {
#pragma unroll
            for (int j = 0; j < 4; ++j) { x1[j] *= 0.08838834764831845f; x2[j] *= 0.08838834764831845f; }
          } else if (mode == 2) {
            if (rr_of(m) < SEQ) {
              const f32x4 cs = *(const f32x4*)(rope + (long)rr_of(m) * 64 + ci);
              const f32x4 sn = *(const f32x4*)(rope + (long)rr_of(m) * 64 + 32 + ci);
#pragma unroll
              for (int j = 0; j < 4; ++j) { const float a = x1[j], bb = x2[j]; x1[j] = a * cs[j] - bb * sn[j]; x2[j] = a * sn[j] + bb * cs[j]; }
            }
          } else if (mode == 3) {
#pragma unroll
            for (int j = 0; j < 4; ++j) { x1[j] = sigmf(x1[j]); x2[j] = sigmf(x2[j]); }
          }
          lds_put4(wl, 272, mi * 32 + r32, cg2 * 64 + ci, x1[0], x1[1], x1[2], x1[3]);
          lds_put4(wl, 272, mi * 32 + r32, cg2 * 64 + 32 + ci, x2[0], x2[1], x2[2], x2[3]);
        }
      }
    }
    wave_tile_store<128>(wl, feat + (long)(m0 + wm * 64) * NF + n0 + wn * 128, NF, lane);
  }
}

DEVI void phase_gemm_up(const Params& p, int l, char* lds) {
  const u16* feat = (const u16*)(p.ws + OFF_FEAT);
  const float* rope = (const float*)(p.ws + OFF_ROPE);
  float* rs = (float*)(lds + 98304);
  const int tid = otid(), lane = tid & 63, wid = tid >> 6, r32 = lane & 31, hi = lane >> 5, wm = wid & 3, wn = wid >> 2;
  constexpr int NTM = RP / 256, NQ = 12, NK = 16;
  for (int tile = vblock(); tile < NTM * (NQ + NK); tile += gridDim.x) {
    int tm, tn; tile_map(tile, NTM, NQ + NK, tm, tn);
    const bool isq = tn < NQ;
    const int m0 = tm * 256, n0 = (isq ? tn : tn - NQ) * 128;
    const int K = isq ? 256 : 128;
    const u16* A = feat + (long)m0 * NF + (isq ? F_MQ : F_MKV);
    const u16* W = isq ? ((const u16*)(p.ws + OFF_WUQ) + (long)l * 1536 * 256 + (long)n0 * 256)
                       : ((const u16*)(p.ws + OFF_WUKV) + (long)l * 2048 * 128 + (long)n0 * 128);
    __syncthreads();
    {
      const int row = tid >> 1, half = tid & 1, n8 = K / 16;
      const u16* ap = A + (long)row * NF + half * (K / 2);
      float ss = 0.f;
      for (int i = 0; i < n8; ++i) {
        const u32x4 w = *(const u32x4*)(ap + i * 8);
#pragma unroll
        for (int j = 0; j < 4; ++j) { const float a = bflo(w[j]), b = bfhi(w[j]); ss += a * a + b * b; }
      }
      ss += __shfl_xor(ss, 1);
      if (half == 0) rs[row] = rsqrtf(ss / (float)K + EPS);
    }
    f32x16 acc[2][2];
    gemm_kloop<2, 1>(acc, A, NF, W, K, K, lds);
    const int cb = n0 + wn * 64;
    const bool dorope = isq && ((cb % 192) == 128);
    u16* outp = isq ? (u16*)(p.ws + OFF_QM) : (u16*)(p.ws + OFF_KV);
    const int ldo = isq ? 1536 : 2048;
    char* wl = lds + wid * (64 * 144);
#pragma unroll
    for (int mi = 0; mi < 2; ++mi) {
      const int ml = wm * 64 + mi * 32 + r32, m = m0 + ml;
      const float sc = rs[ml];
#pragma unroll
      for (int q = 0; q < 4; ++q) {
        const int ci = q * 8 + hi * 4;
        float x1[4], x2[4];
#pragma unroll
        for (int j = 0; j < 4; ++j) { x1[j] = acc[0][mi][q * 4 + j] * sc; x2[j] = acc[1][mi][q * 4 + j] * sc; }
        if (dorope && rr_of(m) < SEQ) {
          const f32x4 cs = *(const f32x4*)(rope + (long)rr_of(m) * 64 + ci);
          const f32x4 sn = *(const f32x4*)(rope + (long)rr_of(m) * 64 + 32 + ci);
#pragma unroll
          for (int j = 0; j < 4; ++j) { const float a = x1[j], bb = x2[j]; x1[j] = a * cs[j] - bb * sn[j]; x2[j] = a * sn[j] + bb * cs[j]; }
        }
        lds_put4(wl, 144, mi * 32 + r32, ci, x1[0], x1[1], x1[2], x1[3]);
        lds_put4(wl, 144, mi * 32 + r32, 32 + ci, x2[0], x2[1], x2[2], x2[3]);
      }
    }
    wave_tile_store<64>(wl, outp + (long)(m0 + wm * 64) * ldo + cb, ldo, lane);
  }
}

DEVI void phase_gemm_br(const Params& p, int l, char* lds) {
  const u16* feat = (const u16*)(p.ws + OFF_FEAT);
  u16* Y = (u16*)(p.ws + OFF_Y);
  const int lane = otid() & 63, wid = otid() >> 6, r32 = lane & 31, hi = lane >> 5, wm = wid & 3, wn = wid >> 2;
  const int NTM = tile_ntm(l, 128);
  for (int tile = vblock(); tile < NTM * 8; tile += gridDim.x) {
    int tm, tn; tile_map(tile, NTM, 8, tm, tn);
    const int m0 = tile_m0(tm, l, 128), n0 = tn * 128;
    const int m = m0 + wm * 32 + r32;
    f32x16 tot[2];
#pragma unroll
    for (int i = 0; i < 3; ++i) {
      const u16* A = (const u16*)(p.ws + (i == 0 ? OFF_YA : (i == 1 ? OFF_YB : OFF_YC))) + (long)m0 * 1024;
      const u16* W = (const u16*)(p.ws + OFF_WBR) + ((long)(l * 3 + i) * 1024 + n0) * 1024;
      f32x16 acc[2][1];
      gemm_kloop<1, 1>(acc, A, 1024, W, 1024, 1024, lds);
#pragma unroll
      for (int ni = 0; ni < 2; ++ni)
#pragma unroll
        for (int q = 0; q < 4; ++q) {
          const int n = n0 + wn * 64 + ni * 32 + q * 8 + hi * 4;
          const u32x2 g = *(const u32x2*)(feat + (long)m * NF + F_GATE + i * 1024 + n);
          const float g0 = bflo(g[0]), g1 = bfhi(g[0]), g2 = bflo(g[1]), g3 = bfhi(g[1]);
          if (i == 0) {
            tot[ni][q * 4 + 0] = g0 * acc[ni][0][q * 4 + 0]; tot[ni][q * 4 + 1] = g1 * acc[ni][0][q * 4 + 1];
            tot[ni][q * 4 + 2] = g2 * acc[ni][0][q * 4 + 2]; tot[ni][q * 4 + 3] = g3 * acc[ni][0][q * 4 + 3];
          } else {
            tot[ni][q * 4 + 0] += g0 * acc[ni][0][q * 4 + 0]; tot[ni][q * 4 + 1] += g1 * acc[ni][0][q * 4 + 1];
            tot[ni][q * 4 + 2] += g2 * acc[ni][0][q * 4 + 2]; tot[ni][q * 4 + 3] += g3 * acc[ni][0][q * 4 + 3];
          }
        }
    }
#pragma unroll
    for (int ni = 0; ni < 2; ++ni)
#pragma unroll
      for (int q = 0; q < 4; ++q) {
        const int n = n0 + wn * 64 + ni * 32 + q * 8 + hi * 4;
        st4bf(Y + (long)m * 1024 + n, tot[ni][q * 4 + 0], tot[ni][q * 4 + 1], tot[ni][q * 4 + 2], tot[ni][q * 4 + 3]);
      }
  }
}

DEVI void phase_gemm_res(const Params& p, int ps, int l, int which, char* lds) {
  const int lane = otid() & 63, wid = otid() >> 6, r32 = lane & 31, hi = lane >> 5, wm = wid & 3, wn = wid >> 2;
  const int NTM = tile_ntm(l, 128);
  const bool first = (which == 2);
  const int K = first ? 1024 : FH;
  const u16* Abase = first ? (const u16*)(p.ws + OFF_Y) : (const u16*)(p.ws + OFF_HID);
  const u16* Wbase = first ? ((const u16*)(p.ws + OFF_WOUT) + (long)l * 1024 * 1024) : ((const u16*)(p.ws + OFF_WF2) + (long)l * 1024 * FH);
  for (int tile = vblock(); tile < NTM * 8; tile += gridDim.x) {
    int tm, tn; tile_map(tile, NTM, 8, tm, tn);
    const int m0 = tile_m0(tm, l, 128), n0 = tn * 128;
    f32x16 acc[2][1];
    gemm_kloop<1, 1>(acc, Abase + (long)m0 * K, K, Wbase + (long)n0 * K, K, K, lds);
    const int m = m0 + wm * 32 + r32;
    const float* gv = modvec(p, l, ps, m, which);
    float* dst = xrow(p, ps, m);
    const float* xin = dst;
    if (first && l == 0) xin = inrow(p, ps, m);
#pragma unroll
    for (int ni = 0; ni < 2; ++ni)
#pragma unroll
      for (int q = 0; q < 4; ++q) {
        const int n = n0 + wn * 64 + ni * 32 + q * 8 + hi * 4;
        const f32x4 xi = *(const f32x4*)(xin + n);
        const f32x4 g = *(const f32x4*)(gv + n);
        f32x4 o;
#pragma unroll
        for (int j = 0; j < 4; ++j) o[j] = ALPHA * xi[j] + g[j] * acc[ni][0][q * 4 + j];
        *(f32x4*)(dst + n) = o;
      }
  }
}

DEVI void phase_gemm_f1(const Params& p, int l, char* lds) {
  const u16* H = (const u16*)(p.ws + OFF_H);
  const u16* W = (const u16*)(p.ws + OFF_WF1) + (long)l * 5632 * 1024;
  u16* hid = (u16*)(p.ws + OFF_HID);
  const int lane = otid() & 63, wid = otid() >> 6, r32 = lane & 31, hi = lane >> 5, wm = wid & 3, wn = wid >> 2;
  const int NTM = tile_ntm(l, 256);
  for (int tile = vblock(); tile < NTM * 22; tile += gridDim.x) {
    int tm, tn; tile_map(tile, NTM, 22, tm, tn);
    const int m0 = tile_m0(tm, l, 256), n0 = tn * 256;
    f32x16 acc[4][2];
    __syncthreads();
    gemm_kloop<2, 2>(acc, H + (long)m0 * 1024, 1024, W + (long)n0 * 1024, 1024, 1024, lds);
    char* wl = lds + wid * (64 * 144);
#pragma unroll
    for (int cg2 = 0; cg2 < 2; ++cg2) {
#pragma unroll
      for (int mi = 0; mi < 2; ++mi) {
#pragma unroll
        for (int q = 0; q < 4; ++q) {
          float h[4];
#pragma unroll
          for (int j = 0; j < 4; ++j) h[j] = siluf(acc[2 * cg2][mi][q * 4 + j]) * acc[2 * cg2 + 1][mi][q * 4 + j];
          lds_put4(wl, 144, mi * 32 + r32, cg2 * 32 + q * 8 + hi * 4, h[0], h[1], h[2], h[3]);
        }
      }
    }
    wave_tile_store<64>(wl, hid + (long)(m0 + wm * 64) * FH + (tn * 4 + wn * 2) * 32, FH, lane);
  }
}

DEVI void phase_prep(const Params& p, int l) {
  const int lane = otid() & 63;
  const int gw = blockIdx.x * 8 + (otid() >> 6), nw = gridDim.x * 8;
  const float lam_init = 0.8f - 0.6f * expf(-0.3f * (float)l);
  const float* dl = p.diff_lam + l * 256;
  const float s01 = wave_sum(dl[lane] * dl[64 + lane]), s23 = wave_sum(dl[128 + lane] * dl[192 + lane]);
  const float lam = expf(s01) - expf(s23) + lam_init;
  const u16* feat = (const u16*)(p.ws + OFF_FEAT);
  const u16* og0 = (const u16*)(p.ws + OFF_OG); const u16* og1 = og0 + (long)RP * 1024;
  const u16* od0 = (const u16*)(p.ws + OFF_OD); const u16* od1 = od0 + (long)RP * 1024;
  u16* ya = (u16*)(p.ws + OFF_YA); u16* yb = (u16*)(p.ws + OFF_YB);
  const f32x4 gg = *(const f32x4*)(p.gla_norm_g + l * 256 + lane * 4);
  const float dg0 = p.diff_norm_g[l * 128 + lane * 2] * (1.f - lam_init), dg1 = p.diff_norm_g[l * 128 + lane * 2 + 1] * (1.f - lam_init);
  for (int r = gw; r < RP; r += nw) {
    if (l == 1 && rr_of(r) >= SEQ) continue;
    u32x2 ga[4], gb[4], gr[4]; unsigned da[8], db[8];
#pragma unroll
    for (int u = 0; u < 4; ++u) {
      const long off = (long)r * 1024 + u * 256 + lane * 4;
      ga[u] = *(const u32x2*)(og0 + off); gb[u] = *(const u32x2*)(og1 + off);
      gr[u] = *(const u32x2*)(feat + (long)r * NF + F_GR + u * 256 + lane * 4);
    }
#pragma unroll
    for (int h = 0; h < 8; ++h) {
      const long off = (long)r * 1024 + h * 128 + lane * 2;
      da[h] = *(const unsigned*)(od0 + off); db[h] = *(const unsigned*)(od1 + off);
    }
    float o[4][4], ss[4], e0[8], e1[8], sd[8];
#pragma unroll
    for (int u = 0; u < 4; ++u) {
      o[u][0] = bflo(ga[u][0]) + bflo(gb[u][0]); o[u][1] = bfhi(ga[u][0]) + bfhi(gb[u][0]);
      o[u][2] = bflo(ga[u][1]) + bflo(gb[u][1]); o[u][3] = bfhi(ga[u][1]) + bfhi(gb[u][1]);
      ss[u] = o[u][0] * o[u][0] + o[u][1] * o[u][1] + o[u][2] * o[u][2] + o[u][3] * o[u][3];
    }
#pragma unroll
    for (int h = 0; h < 8; ++h) {
      e0[h] = bflo(da[h]) - lam * bflo(db[h]); e1[h] = bfhi(da[h]) - lam * bfhi(db[h]);
      sd[h] = e0[h] * e0[h] + e1[h] * e1[h];
    }
#pragma unroll
    for (int m = 32; m >= 1; m >>= 1) {
#pragma unroll
      for (int u = 0; u < 4; ++u) ss[u] += __shfl_xor(ss[u], m);
#pragma unroll
      for (int h = 0; h < 8; ++h) sd[h] += __shfl_xor(sd[h], m);
    }
#pragma unroll
    for (int u = 0; u < 4; ++u) {
      const float rsd = rsqrtf(ss[u] * (1.f / 256.f) + EPS);
      const float rv[4] = {bflo(gr[u][0]), bfhi(gr[u][0]), bflo(gr[u][1]), bfhi(gr[u][1])};
      float y[4];
#pragma unroll
      for (int j = 0; j < 4; ++j) y[j] = o[u][j] * rsd * gg[j] * siluf(rv[j]);
      st4bf(ya + (long)r * 1024 + u * 256 + lane * 4, y[0], y[1], y[2], y[3]);
    }
#pragma unroll
    for (int h = 0; h < 8; ++h) {
      const float rsd = rsqrtf(sd[h] * (1.f / 128.f) + EPS);
      *(unsigned*)(yb + (long)r * 1024 + h * 128 + lane * 2) = cvtpk(e0[h] * rsd * dg0, e1[h] * rsd * dg1);
    }
  }
}

DEVI int v_st(int k, int c) { const int kk = (k & ~0xC) | ((k & 4) << 1) | ((k & 8) >> 1); return ((kk >> 3) * 4 + (c >> 5)) * 512 + ((kk & 7) * 32 + (c & 31)) * 2; }
DEVI int v_rd_base(int lane) { return ((lane & 3) << 3) | (((lane >> 2) & 3) << 6) | (((lane >> 4) & 1) << 5) | (((lane >> 5) & 1) << 8); }
constexpr int v_rd_off(int d0, int ks, int half) { return d0 * 512 + ks * 4096 + half * 2048; }
template <int OFF> DEVI s16x4 tr_read(int vb) {
  s16x4 r; asm volatile("ds_read_b64_tr_b16 %0, %1 offset:%2" : "=&v"(r) : "v"(vb), "i"(OFF) : "memory"); return r;
}
template <int D0> DEVI void pv_one(f32x16& od, int vb, bf16x8 pa0, bf16x8 pa1, bf16x8 pa2, bf16x8 pa3) {
  const s16x4 l0 = tr_read<v_rd_off(D0, 0, 0)>(vb), h0 = tr_read<v_rd_off(D0, 0, 1)>(vb), l1 = tr_read<v_rd_off(D0, 1, 0)>(vb), h1 = tr_read<v_rd_off(D0, 1, 1)>(vb);
  const s16x4 l2 = tr_read<v_rd_off(D0, 2, 0)>(vb), h2 = tr_read<v_rd_off(D0, 2, 1)>(vb), l3 = tr_read<v_rd_off(D0, 3, 0)>(vb), h3 = tr_read<v_rd_off(D0, 3, 1)>(vb);
  asm volatile("s_waitcnt lgkmcnt(0)" ::: "memory"); SBAR();
#define PK(L, H) (bf16x8){L[0], L[1], L[2], L[3], H[0], H[1], H[2], H[3]}
  od = __builtin_amdgcn_mfma_f32_32x32x16_bf16(pa0, PK(l0, h0), od, 0, 0, 0);
  od = __builtin_amdgcn_mfma_f32_32x32x16_bf16(pa1, PK(l1, h1), od, 0, 0, 0);
  od = __builtin_amdgcn_mfma_f32_32x32x16_bf16(pa2, PK(l2, h2), od, 0, 0, 0);
  od = __builtin_amdgcn_mfma_f32_32x32x16_bf16(pa3, PK(l3, h3), od, 0, 0, 0);
#undef PK
}
DEVI void pv_d0(f32x16* o, int vb, bf16x8 pa0, bf16x8 pa1, bf16x8 pa2, bf16x8 pa3) {
  pv_one<0>(o[0], vb, pa0, pa1, pa2, pa3); pv_one<1>(o[1], vb, pa0, pa1, pa2, pa3); pv_one<2>(o[2], vb, pa0, pa1, pa2, pa3); pv_one<3>(o[3], vb, pa0, pa1, pa2, pa3);
}
constexpr float ATT_THR = 8.f;
DEVI void partialSM(f32x16& p0, f32x16& p1, float& m_reg, float& mn, float& alpha, float scale) {
  const float C = scale * 1.4426950408889634f;
  float pmax = p0[0];
#pragma unroll
  for (int r = 1; r < 16; ++r) pmax = fmaxf(pmax, p0[r]);
#pragma unroll
  for (int r = 0; r < 16; ++r) pmax = fmaxf(pmax, p1[r]);
  { auto rr = __builtin_amdgcn_permlane32_swap(__float_as_uint(pmax), __float_as_uint(pmax), false, false);
    pmax = fmaxf(__uint_as_float(rr[0]), __uint_as_float(rr[1])); }
  if (__builtin_expect(__all(pmax - m_reg <= ATT_THR / scale), 1)) { mn = m_reg; alpha = 1.f; }
  else { mn = fmaxf(m_reg, pmax); alpha = __builtin_amdgcn_exp2f((m_reg - mn) * C); m_reg = mn; }
  const float mnC = -mn * C;
#pragma unroll
  for (int r = 0; r < 16; ++r) p0[r] = fmaf(p0[r], C, mnC);
#pragma unroll
  for (int r = 0; r < 16; ++r) p1[r] = fmaf(p1[r], C, mnC);
#pragma unroll
  for (int r = 0; r < 16; ++r) p0[r] = __builtin_amdgcn_exp2f(p0[r]);
}
#define PK4(P, BASE, OUT) do { unsigned a0 = cvtpk(P[BASE + 0], P[BASE + 1]), a1 = cvtpk(P[BASE + 2], P[BASE + 3]);   \
    unsigned b0 = cvtpk(P[BASE + 4], P[BASE + 5]), b1 = cvtpk(P[BASE + 6], P[BASE + 7]);                              \
    auto r0 = __builtin_amdgcn_permlane32_swap(a0, b0, false, false); auto r1 = __builtin_amdgcn_permlane32_swap(a1, b1, false, false); \
    u32x4 w = {r0[0], r1[0], r0[1], r1[1]}; OUT = *reinterpret_cast<bf16x8*>(&w); } while (0)
DEVI void finishSM(f32x16& p0, f32x16& p1, float alpha, float& l_reg, bf16x8& pa0, bf16x8& pa1, bf16x8& pa2, bf16x8& pa3) {
#pragma unroll
  for (int r = 0; r < 16; ++r) p1[r] = __builtin_amdgcn_exp2f(p1[r]);
  float ps = 0;
#pragma unroll
  for (int r = 0; r < 16; ++r) ps += p0[r];
#pragma unroll
  for (int r = 0; r < 16; ++r) ps += p1[r];
  { auto rr = __builtin_amdgcn_permlane32_swap(__float_as_uint(ps), __float_as_uint(ps), false, false);
    ps = __uint_as_float(rr[0]) + __uint_as_float(rr[1]); }
  l_reg = l_reg * alpha + ps;
  PK4(p0, 0, pa0); PK4(p0, 8, pa1); PK4(p1, 0, pa2); PK4(p1, 8, pa3);
}

template <int DQK, bool PIPE>
DEVI void attn_body(const u16* __restrict__ Qb, int ldq, const u16* __restrict__ K0, int ldk0, const u16* __restrict__ K1, int ldk1,
                    const u16* __restrict__ Vh, int ldv, u16* __restrict__ Ob, int ldo, int seq, float scale, char* lds) {
  constexpr int KRB = DQK * 2, SHM_K = 64 * KRB, SHM_V = 16384, ND0 = DQK / 16, NCH = DQK / 8, NKC = (64 * NCH) / NTHREADS;
  const int tid = otid(), wid = tid >> 6, lane = tid & 63, r32 = lane & 31, hi = lane >> 5;
  char* V_lds = lds; char* K_lds = lds + 2 * SHM_V;
  float* wsf = (float*)(lds + 2 * SHM_V + 2 * SHM_K) + wid * 64; float* li_l = wsf; float* al_l = wsf + 32;
  float m_reg = -1e30f, l_reg = 0; f32x16 o[4];
#pragma unroll
  for (int d = 0; d < 4; ++d)
#pragma unroll
    for (int r = 0; r < 16; ++r) o[d][r] = 0.f;
  bf16x8 qr[ND0];
  const u16* Qw = Qb + (long)(wid * 32 + r32) * ldq + hi * 8;
#pragma unroll
  for (int d0 = 0; d0 < ND0; ++d0) qr[d0] = *(const bf16x8*)(Qw + d0 * 16);
  const int sr = tid >> 4, sc = (tid & 15) * 8, vst0 = v_st(sr, sc), vst1 = v_st(32 + sr, sc);
  const int vb0 = (int)(uintptr_t)V_lds + v_rd_base(lane);
  bf16x8 vs0, vs1, ksg[NKC];
  const int krow0 = (DQK == 64) ? (tid >> 3) : (tid >> 4), kchk0 = (DQK == 64) ? (tid & 7) : (tid & 15);
  const u16* kp0 = K0 + (long)krow0 * ldk0 + kchk0 * 8;
  const int koff0 = krow0 * KRB + ((kchk0 * 16) ^ (((krow0 >> 1) & 7) << 4));
  const int koff1 = (krow0 + 32) * KRB + ((kchk0 * 16) ^ (((krow0 >> 1) & 7) << 4));
  const int krow2 = tid >> 3, kchk2 = 16 + (tid & 7);
  const u16* kp2 = K1 + (long)krow2 * ldk1 + (tid & 7) * 8;
  const int koff2 = krow2 * KRB + ((kchk2 * 16) ^ (((krow2 >> 1) & 7) << 4));
  const u16* vp0 = Vh + (long)sr * ldv + sc;
#define SLOAD(k0) do { vs0 = *(const bf16x8*)(vp0 + (long)(k0) * ldv); vs1 = *(const bf16x8*)(vp0 + (long)((k0) + 32) * ldv); \
    ksg[0] = *(const bf16x8*)(kp0 + (long)(k0) * ldk0); \
    if constexpr (DQK == 192) { ksg[1] = *(const bf16x8*)(kp0 + (long)((k0) + 32) * ldk0); ksg[2] = *(const bf16x8*)(kp2 + (long)(k0) * ldk1); } } while (0)
#define SWRITE(b) do { *(bf16x8*)(V_lds + (b) * SHM_V + vst0) = vs0; *(bf16x8*)(V_lds + (b) * SHM_V + vst1) = vs1; \
    *(bf16x8*)(K_lds + (b) * SHM_K + koff0) = ksg[0]; \
    if constexpr (DQK == 192) { *(bf16x8*)(K_lds + (b) * SHM_K + koff1) = ksg[1]; *(bf16x8*)(K_lds + (b) * SHM_K + koff2) = ksg[2]; } } while (0)
#define SWAIT() asm volatile("s_waitcnt vmcnt(0)" ::: "memory")
#define RESC(a) do { if (__any((a) < 1.f)) { if (hi == 0) al_l[r32] = (a); asm volatile("s_waitcnt lgkmcnt(0)" ::: "memory"); \
    _Pragma("unroll") for (int d = 0; d < 4; ++d) _Pragma("unroll") for (int r = 0; r < 16; ++r) o[d][r] *= al_l[crow(r, hi)]; } } while (0)
#define QKT(P0, P1, KB) do { _Pragma("unroll") for (int r_ = 0; r_ < 16; ++r_) { P0[r_] = 0.f; P1[r_] = 0.f; } \
    _Pragma("unroll") for (int d0 = 0; d0 < ND0; ++d0) { const int cb_ = (d0 * 16 + hi * 8) * 2; \
      bf16x8 b0_ = *(const bf16x8*)((KB) + r32 * KRB + (cb_ ^ (((r32 >> 1) & 7) << 4))); \
      bf16x8 b1_ = *(const bf16x8*)((KB) + (32 + r32) * KRB + (cb_ ^ (((r32 >> 1) & 7) << 4))); \
      P0 = __builtin_amdgcn_mfma_f32_32x32x16_bf16(b0_, qr[d0], P0, 0, 0, 0); \
      P1 = __builtin_amdgcn_mfma_f32_32x32x16_bf16(b1_, qr[d0], P1, 0, 0, 0); } } while (0)
#define KLD0_(KB, d) (*(const bf16x8*)((KB) + r32 * KRB + ((((d) * 16 + hi * 8) * 2) ^ (((r32 >> 1) & 7) << 4))))
#define KLD1_(KB, d) (*(const bf16x8*)((KB) + (32 + r32) * KRB + ((((d) * 16 + hi * 8) * 2) ^ (((r32 >> 1) & 7) << 4))))
#define QKT_RING(P0, P1, KB) do { _Pragma("unroll") for (int r_ = 0; r_ < 16; ++r_) { P0[r_] = 0.f; P1[r_] = 0.f; } \
    bf16x8 ka_[3], kb_[3]; ka_[0] = KLD0_(KB, 0); kb_[0] = KLD1_(KB, 0); ka_[1] = KLD0_(KB, 1); kb_[1] = KLD1_(KB, 1); \
    _Pragma("unroll") for (int d0 = 0; d0 < ND0; ++d0) { \
      if (d0 + 2 < ND0) { ka_[(d0 + 2) % 3] = KLD0_(KB, d0 + 2); kb_[(d0 + 2) % 3] = KLD1_(KB, d0 + 2); } \
      SBAR(); \
      P0 = __builtin_amdgcn_mfma_f32_32x32x16_bf16(ka_[d0 % 3], qr[d0], P0, 0, 0, 0); \
      P1 = __builtin_amdgcn_mfma_f32_32x32x16_bf16(kb_[d0 % 3], qr[d0], P1, 0, 0, 0); \
      SBAR(); } } while (0)
  bf16x8 pa0, pa1, pa2, pa3; const int NT = seq / 64;
  if constexpr (PIPE) {
    f32x16 pA0, pA1, pB0, pB1; float mnA, mnB, alA, alB;
    SLOAD(0); SWAIT(); SWRITE(0); __syncthreads();
    QKT(pA0, pA1, K_lds); partialSM(pA0, pA1, m_reg, mnA, alA, scale);
    SLOAD(64);
    SWAIT(); SWRITE(1); __syncthreads();
    for (int j = 1; j + 1 < NT; j += 2) {
      SBAR(); QKT(pB0, pB1, K_lds + SHM_K);
      finishSM(pA0, pA1, alA, l_reg, pa0, pa1, pa2, pa3); SBAR();
      SLOAD((j + 1) * 64); SBAR();
      pv_d0(o, vb0, pa0, pa1, pa2, pa3); partialSM(pB0, pB1, m_reg, mnB, alB, scale);
      __syncthreads(); SWAIT(); SWRITE(0);
      RESC(alB); __syncthreads();
      SBAR(); QKT(pA0, pA1, K_lds);
      finishSM(pB0, pB1, alB, l_reg, pa0, pa1, pa2, pa3); SBAR();
      SLOAD((j + 2) * 64); SBAR();
      pv_d0(o, vb0 + SHM_V, pa0, pa1, pa2, pa3); partialSM(pA0, pA1, m_reg, mnA, alA, scale);
      __syncthreads(); SWAIT(); SWRITE(1);
      RESC(alA); __syncthreads();
    }
    SBAR(); QKT(pB0, pB1, K_lds + SHM_K);
    finishSM(pA0, pA1, alA, l_reg, pa0, pa1, pa2, pa3); SBAR();
    pv_d0(o, vb0, pa0, pa1, pa2, pa3); partialSM(pB0, pB1, m_reg, mnB, alB, scale);
    __syncthreads(); RESC(alB);
    finishSM(pB0, pB1, alB, l_reg, pa0, pa1, pa2, pa3); SBAR();
    pv_d0(o, vb0 + SHM_V, pa0, pa1, pa2, pa3);
  } else {
    f32x16 p0, p1; float mn, al;
    SLOAD(0); SWAIT(); SWRITE(0); __syncthreads();
    for (int j = 0; j < NT; ++j) {
      const int bsel = j & 1;
      if (j + 1 < NT) SLOAD((j + 1) * 64);
      SBAR(); QKT_RING(p0, p1, K_lds + bsel * SHM_K);
      partialSM(p0, p1, m_reg, mn, al, scale);
      RESC(al);
      finishSM(p0, p1, al, l_reg, pa0, pa1, pa2, pa3); SBAR();
      pv_d0(o, vb0 + bsel * SHM_V, pa0, pa1, pa2, pa3);
      if (j + 1 < NT) { SWAIT(); SWRITE(bsel ^ 1); }
      __syncthreads();
    }
  }
  if (hi == 0) li_l[r32] = l_reg; asm volatile("s_waitcnt lgkmcnt(0)" ::: "memory");
  float rli[16];
#pragma unroll
  for (int r = 0; r < 16; ++r) rli[r] = __builtin_amdgcn_rcpf(li_l[crow(r, hi)]);
  u16* Ow = Ob + (long)(wid * 32) * ldo;
#pragma unroll
  for (int r = 0; r < 16; ++r) { const int orow = crow(r, hi);
#pragma unroll
    for (int d0 = 0; d0 < 4; ++d0) Ow[(long)orow * ldo + d0 * 32 + r32] = f2bf(o[d0][r] * rli[r]); }
  __syncthreads();
#undef SLOAD
#undef SWRITE
#undef SWAIT
#undef RESC
#undef QKT
#undef QKT_RING
#undef KLD0_
#undef KLD1_
}

DEVI long gla_row(int bi, int dir, int cc, int i) {
  const int L = (cc < 4) ? CTXL : SEQ, c = (cc < 4) ? cc : cc - 4, rb = bi * ROWS + ((cc < 4) ? SEQ : 0);
  const int tl = c * 64 + i;
  return (long)(rb + (dir ? (L - 1 - tl) : tl));
}
DEVI void gla_seq(const Params& p, int l, int item, char* lds) {
  const int tid = otid(), wid = tid >> 6, lane = tid & 63, r32 = lane & 31, hi = lane >> 5;
  const int bi = item >> 5, h = (item >> 3) & 3, dir = (item >> 2) & 1, sl = item & 3;
  char* qs = lds;
  char* ks = lds + 16384;
  char* kT = lds + 32768;
  char* vT = lds + 32768 + 18432;
  char* sT = lds + 32768 + 18432 + 9216;
  float* gas = (float*)(sT + 32768);
  float* segtot = gas + 1024;
  float* ebl = segtot + 512;
  const u16* feat = (const u16*)(p.ws + OFF_FEAT);
  u16* og = (u16*)(p.ws + OFF_OG) + (long)dir * RP * 1024;
  const int d = tid & 127, seg = tid >> 7;
  float w2[16];
#pragma unroll
  for (int r = 0; r < 16; ++r) w2[r] = p.gla_w_a2[(((long)l * 2 + dir) * 16 + r) * 512 + h * 128 + d];
  const float ba = p.gla_b_a[((long)l * 2 + dir) * 512 + h * 128 + d];
  __syncthreads();
  for (int i = tid; i < 8192; i += NTHREADS) ((unsigned*)sT)[i] = 0u;
  f32x16 Sacc;
#pragma unroll
  for (int r = 0; r < 16; ++r) Sacc[r] = 0.f;
  const int dblk = wid >> 1, eblk = wid & 1, iblk = (wid >> 1) & 1;
  u32x4 pq0, pq1, pk0, pk1, pv; u16 pg0, pg1;
  const int row0 = tid >> 4, chq = tid & 15;
  const int vi0 = tid >> 3, ve8 = (tid & 7) * 8;
  const int g0i = (tid * 2) >> 4, g0r = (tid * 2) & 15;
#define GLOADC(cc_) do { \
    const u16* f0_ = feat + gla_row(bi, dir, (cc_), row0) * NF + h * 128 + chq * 8; \
    const u16* f1_ = feat + gla_row(bi, dir, (cc_), 32 + row0) * NF + h * 128 + chq * 8; \
    pq0 = *(const u32x4*)(f0_ + F_GQ); pk0 = *(const u32x4*)(f0_ + F_GK); pq1 = *(const u32x4*)(f1_ + F_GQ); pk1 = *(const u32x4*)(f1_ + F_GK); \
    pv = *(const u32x4*)(feat + gla_row(bi, dir, (cc_), vi0) * NF + F_GV + h * 256 + sl * 64 + ve8); \
    const u16* g_ = feat + gla_row(bi, dir, (cc_), g0i) * NF + F_GA + dir * 16 + g0r; pg0 = g_[0]; pg1 = g_[1]; } while (0)
  GLOADC(0);
  int cur = 0;
  for (int cc = 0; cc < 132; ++cc) {
    {
      const int so0 = row0 * 256 + ((chq ^ (row0 & 7)) << 4), so1 = so0 + 32 * 256;
      *(u32x4*)(qs + so0) = pq0; *(u32x4*)(ks + so0) = pk0; *(u32x4*)(qs + so1) = pq1; *(u32x4*)(ks + so1) = pk1;
#pragma unroll
      for (int j = 0; j < 4; ++j) {
        *(u16*)(vT + (ve8 + 2 * j) * 144 + vi0 * 2) = (u16)(pv[j] & 0xffffu);
        *(u16*)(vT + (ve8 + 2 * j + 1) * 144 + vi0 * 2) = (u16)(pv[j] >> 16);
      }
      gas[tid * 2] = bf2f(pg0); gas[tid * 2 + 1] = bf2f(pg1);
    }
    __syncthreads();
    if (cc + 1 < 132) GLOADC(cc + 1);
    SBAR();
    float bcum[16];
    {
      float run = 0.f;
#pragma unroll
      for (int ii = 0; ii < 16; ++ii) {
        const float* gr_ = gas + (seg * 16 + ii) * 16;
        float z = ba;
#pragma unroll
        for (int r = 0; r < 16; ++r) z += gr_[r] * w2[r];
        const float ls = fminf(z, 0.f) - __logf(1.f + __expf(-fabsf(z)));
        run += ls * (1.f / 16.f);
        bcum[ii] = run;
      }
      segtot[seg * 128 + d] = run;
    }
    __syncthreads();
    {
      float pre = 0.f, tot = 0.f;
#pragma unroll
      for (int s_ = 0; s_ < 4; ++s_) { const float v = segtot[s_ * 128 + d]; tot += v; if (s_ < seg) pre += v; }
      const float etot = __expf(tot);
      if (seg == 0) ebl[d] = etot;
#pragma unroll
      for (int ii = 0; ii < 16; ++ii) {
        const int i = seg * 16 + ii;
        const float bb = bcum[ii] + pre;
        const int so = i * 256 + (((d >> 3) ^ (i & 7)) << 4) + (d & 7) * 2;
        const float q = bf2f(*(const u16*)(qs + so)), k = bf2f(*(const u16*)(ks + so));
        const float eb = __expf(bb), ieb = __frcp_rn(eb);
        *(u16*)(qs + so) = f2bf(q * eb);
        *(u16*)(ks + so) = f2bf(k * ieb);
        *(u16*)(kT + d * 144 + i * 2) = f2bf(k * (etot * ieb));
      }
    }
    __syncthreads();
    const char* sTc = sT + cur * 16384; char* sTn = sT + (cur ^ 1) * 16384;
    if (wid < 4) {
      f32x16 p0, p1, o;
#pragma unroll
      for (int r = 0; r < 16; ++r) { p0[r] = 0.f; p1[r] = 0.f; o[r] = 0.f; }
      const int irow = iblk * 32 + r32;
#pragma unroll
      for (int d0 = 0; d0 < 8; ++d0) {
        const int chn = d0 * 2 + hi;
        const bf16x8 b0 = *(const bf16x8*)(ks + r32 * 256 + ((chn ^ (r32 & 7)) << 4));
        const bf16x8 b1 = *(const bf16x8*)(ks + (32 + r32) * 256 + ((chn ^ (r32 & 7)) << 4));
        const bf16x8 qf = *(const bf16x8*)(qs + irow * 256 + ((chn ^ (irow & 7)) << 4));
        p0 = __builtin_amdgcn_mfma_f32_32x32x16_bf16(b0, qf, p0, 0, 0, 0);
        p1 = __builtin_amdgcn_mfma_f32_32x32x16_bf16(b1, qf, p1, 0, 0, 0);
      }
#pragma unroll
      for (int r = 0; r < 16; ++r) {
        const int j0 = crow(r, hi), j1 = 32 + j0;
        const bool k0 = dir ? (j0 < irow) : (j0 <= irow), k1 = dir ? (j1 < irow) : (j1 <= irow);
        p0[r] = k0 ? p0[r] : 0.f; p1[r] = k1 ? p1[r] : 0.f;
      }
      bf16x8 pa0, pa1, pa2, pa3;
      PK4(p0, 0, pa0); PK4(p0, 8, pa1); PK4(p1, 0, pa2); PK4(p1, 8, pa3);
      const char* vrow = vT + (eblk * 32 + r32) * 144 + hi * 16;
      o = __builtin_amdgcn_mfma_f32_32x32x16_bf16(pa0, *(const bf16x8*)(vrow), o, 0, 0, 0);
      o = __builtin_amdgcn_mfma_f32_32x32x16_bf16(pa1, *(const bf16x8*)(vrow + 32), o, 0, 0, 0);
      o = __builtin_amdgcn_mfma_f32_32x32x16_bf16(pa2, *(const bf16x8*)(vrow + 64), o, 0, 0, 0);
      o = __builtin_amdgcn_mfma_f32_32x32x16_bf16(pa3, *(const bf16x8*)(vrow + 96), o, 0, 0, 0);
      const int erow = eblk * 32 + r32;
#pragma unroll
      for (int d0 = 0; d0 < 8; ++d0) {
        const int chn = d0 * 2 + hi;
        const bf16x8 qf = *(const bf16x8*)(qs + irow * 256 + ((chn ^ (irow & 7)) << 4));
        const bf16x8 sf = *(const bf16x8*)(sTc + erow * 256 + ((chn ^ (erow & 7)) << 4));
        o = __builtin_amdgcn_mfma_f32_32x32x16_bf16(qf, sf, o, 0, 0, 0);
      }
#pragma unroll
      for (int r = 0; r < 16; ++r)
        og[gla_row(bi, dir, cc, iblk * 32 + crow(r, hi)) * 1024 + h * 256 + sl * 64 + eblk * 32 + r32] = f2bf(o[r]);
    }
    {
#pragma unroll
      for (int r = 0; r < 16; ++r) Sacc[r] *= ebl[dblk * 32 + crow(r, hi)];
      const char* krow = kT + (dblk * 32 + r32) * 144 + hi * 16;
      const char* vrow = vT + (eblk * 32 + r32) * 144 + hi * 16;
#pragma unroll
      for (int k16 = 0; k16 < 4; ++k16)
        Sacc = __builtin_amdgcn_mfma_f32_32x32x16_bf16(*(const bf16x8*)(krow + k16 * 32), *(const bf16x8*)(vrow + k16 * 32), Sacc, 0, 0, 0);
      const int erow = eblk * 32 + r32;
#pragma unroll
      for (int q4 = 0; q4 < 4; ++q4) {
        const int chn = dblk * 4 + q4;
        u32x2 w = {cvtpk(Sacc[q4 * 4 + 0], Sacc[q4 * 4 + 1]), cvtpk(Sacc[q4 * 4 + 2], Sacc[q4 * 4 + 3])};
        *(u32x2*)(sTn + erow * 256 + ((chn ^ (erow & 7)) << 4) + hi * 8) = w;
      }
    }
    cur ^= 1;
    __syncthreads();
  }
#undef GLOADC
}

DEVI void phase_mix(const Params& p, int ps, int l, char* lds) {
  __shared__ int s_q;
  const u16* feat = (const u16*)(p.ws + OFF_FEAT);
  const u16* qm = (const u16*)(p.ws + OFF_QM);
  const u16* kvb = (const u16*)(p.ws + OFF_KV);
  u16* od = (u16*)(p.ws + OFF_OD);
  u16* yc = (u16*)(p.ws + OFF_YC);
  const int x = blockIdx.x & 7, jb = blockIdx.x >> 3;
  if (jb < 8) gla_seq(p, l, x * 8 + jb, lds);
  int* ctr = (int*)(p.ws + OFF_CTR) + 128 + (ps * 2 + l) * 8 + x;
  const int nmla = NBP * 32, ndiff = NBP * 64, nctx = (l == 0) ? (NBP * 24 / 8) : 0;
  for (;;) {
    __syncthreads();
    if (otid() == 0) s_q = atomicAdd(ctr, 1);
    __syncthreads();
    const int q = s_q;
    if (q >= nmla) break;
    const int bi = q >> 5, h = x, q0 = bi * ROWS + (q & 31) * 256;
    const long k0 = (long)bi * ROWS;
    attn_body<192, false>(qm + (long)q0 * 1536 + h * 192, 1536, kvb + k0 * 2048 + h * 256, 2048, feat + k0 * NF + F_KR, NF,
                          kvb + k0 * 2048 + h * 256 + 128, 2048, yc + (long)q0 * 1024 + h * 128, 1024, ROWS, 0.07216878364870322f, lds);
  }
  int* ctr2 = ctr + 128;
  for (;;) {
    __syncthreads();
    if (otid() == 0) s_q = atomicAdd(ctr2, 1);
    __syncthreads();
    const int q = s_q;
    if (q >= ndiff + nctx) break;
    if (q < ndiff) {
      const int bi = q >> 6, hm = x + 8 * ((q >> 5) & 1), h = hm >> 1, mp = hm & 1, q0 = bi * ROWS + (q & 31) * 256;
      const long k0 = (long)bi * ROWS;
      attn_body<64, true>(feat + (long)q0 * NF + F_DQ + h * 128 + mp * 64, NF, feat + k0 * NF + F_DK + h * 128 + mp * 64, NF, feat, NF,
                          feat + k0 * NF + F_DV + h * 128, NF, od + (long)mp * RP * 1024 + (long)q0 * 1024 + h * 128, 1024, ROWS, 0.125f, lds);
    } else {
      const int u = (q - ndiff) * 8 + x, bi = u / 24, v = u % 24;
      const long c0 = (long)bi * ROWS + SEQ;
      if (v < 8) {
        const int h = v;
        attn_body<192, false>(qm + c0 * 1536 + h * 192, 1536, kvb + c0 * 2048 + h * 256, 2048, feat + c0 * NF + F_KR, NF,
                              kvb + c0 * 2048 + h * 256 + 128, 2048, yc + c0 * 1024 + h * 128, 1024, CTXL, 0.07216878364870322f, lds);
      } else {
        const int h = (v - 8) >> 1, mp = (v - 8) & 1;
        attn_body<64, true>(feat + c0 * NF + F_DQ + h * 128 + mp * 64, NF, feat + c0 * NF + F_DK + h * 128 + mp * 64, NF, feat, NF,
                            feat + c0 * NF + F_DV + h * 128, NF, od + (long)mp * RP * 1024 + c0 * 1024 + h * 128, 1024, CTXL, 0.125f, lds);
      }
    }
  }
}

DEVI void grid_bar(unsigned* ctr, unsigned& epoch) {
  asm volatile("s_waitcnt vmcnt(0)" ::: "memory");
  __syncthreads();
  if (threadIdx.x == 0) {
    __builtin_amdgcn_fence(__ATOMIC_RELEASE, "agent");
    asm volatile("s_waitcnt vmcnt(0)" ::: "memory");
    __hip_atomic_fetch_add(ctr, 1u, __ATOMIC_RELAXED, __HIP_MEMORY_SCOPE_AGENT);
    const unsigned target = (epoch + 1u) * gridDim.x;
    while (__hip_atomic_load(ctr, __ATOMIC_RELAXED, __HIP_MEMORY_SCOPE_AGENT) < target) __builtin_amdgcn_s_sleep(1);
    __builtin_amdgcn_fence(__ATOMIC_ACQUIRE, "agent");
    asm volatile("s_waitcnt vmcnt(0)" ::: "memory");
  }
  __syncthreads();
  ++epoch;
}

__global__ void __launch_bounds__(NTHREADS) fwd_megakernel(Params p) {
  extern __shared__ __attribute__((aligned(16))) char lds[];
  cg::grid_group grid = cg::this_grid();
  if (blockIdx.x == 0) ((int*)(p.ws + OFF_CTR))[threadIdx.x] = 0;
  unsigned* gbar = (unsigned*)(p.ws + OFF_CTR) + 96; unsigned epoch = 0;
  for (int l = 0; l < 2; ++l) {
    conv_weight(p.w_in + (long)l * 1024 * NIN_ORIG, NIN_ORIG, (u16*)(p.ws + OFF_WIN) + (long)l * NF * 1024, NF, 1024, 1, nullptr, lds);
    conv_weight(p.mla_w_uq + (long)l * 256 * 1536, 1536, (u16*)(p.ws + OFF_WUQ) + (long)l * 1536 * 256, 1536, 256, 0, p.mla_q_norm_g + l * 256, lds);
    conv_weight(p.mla_w_ukv + (long)l * 128 * 2048, 2048, (u16*)(p.ws + OFF_WUKV) + (long)l * 2048 * 128, 2048, 128, 0, p.mla_kv_norm_g + l * 128, lds);
    for (int i = 0; i < 3; ++i)
      conv_weight(p.w_branch + ((long)l * 3 + i) * 1024 * 1024, 1024, (u16*)(p.ws + OFF_WBR) + ((long)l * 3 + i) * 1024 * 1024, 1024, 1024, 0, nullptr, lds);
    conv_weight(p.w_out + (long)l * 1024 * 1024, 1024, (u16*)(p.ws + OFF_WOUT) + (long)l * 1024 * 1024, 1024, 1024, 0, nullptr, lds);
    conv_weight(p.ffn_w_in + (long)l * 1024 * 5632, 5632, (u16*)(p.ws + OFF_WF1) + (long)l * 5632 * 1024, 5632, 1024, 2, nullptr, lds);
    conv_weight(p.ffn_w_out + (long)l * FH * 1024, 1024, (u16*)(p.ws + OFF_WF2) + (long)l * 1024 * FH, 1024, FH, 0, nullptr, lds);
  }
  phase_modv(p, lds);
  phase_rope(p);
  grid.sync();
  phase_mod1_l0(p, 0);
  grid_bar(gbar, epoch);
  for (int ps = 0; ps < NPASS; ++ps) {
    for (int l = 0; l < 2; ++l) {
      phase_gemm_in(p, l, lds);              grid_bar(gbar, epoch);
      phase_gemm_up(p, l, lds);              grid_bar(gbar, epoch);
      phase_mix(p, ps, l, lds);              grid_bar(gbar, epoch);
      phase_prep(p, l);                      grid_bar(gbar, epoch);
      phase_gemm_br(p, l, lds);              grid_bar(gbar, epoch);
      phase_gemm_res(p, ps, l, 2, lds);      grid_bar(gbar, epoch);
      phase_rows_a(p, ps, l);                grid_bar(gbar, epoch);
      phase_gemm_f1(p, l, lds);              grid_bar(gbar, epoch);
      phase_gemm_res(p, ps, l, 5, lds);      grid_bar(gbar, epoch);
      phase_rows_b(p, ps, l);                if (!(ps == NPASS - 1 && l == 1)) grid_bar(gbar, epoch);
    }
  }
}

extern "C" void kernel_launch(void* const* d_in, const int* in_sizes, int n_in, void* d_out, int out_size, void* d_ws, size_t ws_size, hipStream_t stream) {
  static int grid_blocks = 0;
  if (grid_blocks == 0) {
    if (n_in != 24 || ws_size < WS_END) { fprintf(stderr, "kernel_launch: n_in %d ws %zu need %zu\n", n_in, ws_size, (size_t)WS_END); grid_blocks = -1; return; }
    int dev = 0, cus = 0, per_cu = 0;
    hipGetDevice(&dev);
    hipDeviceGetAttribute(&cus, hipDeviceAttributeMultiprocessorCount, dev);
    if (hipFuncSetAttribute((const void*)fwd_megakernel, hipFuncAttributeMaxDynamicSharedMemorySize, LDS_BYTES) != hipSuccess) { fprintf(stderr, "kernel_launch: LDS attr failed\n"); grid_blocks = -1; return; }
    hipOccupancyMaxActiveBlocksPerMultiprocessor(&per_cu, (const void*)fwd_megakernel, NTHREADS, LDS_BYTES);
    if (per_cu < 1) { fprintf(stderr, "kernel_launch: occupancy %d\n", per_cu); per_cu = 1; }
    if (per_cu > 1) per_cu = 1;
    grid_blocks = cus * per_cu;
  }
  if (grid_blocks < 0) return;
  Params p{};
  const float** pp = (const float**)&p;
  for (int i = 0; i < 24; ++i) pp[i] = (const float*)d_in[i];
  p.out = (float*)d_out; p.ws = (char*)d_ws;
  void* args[] = {&p};
  hipError_t e = hipLaunchCooperativeKernel((const void*)fwd_megakernel, dim3(grid_blocks), dim3(NTHREADS), args, LDS_BYTES, stream);
  if (e != hipSuccess) fprintf(stderr, "cooperative launch failed: %s (grid %d)\n", hipGetErrorString(e), grid_blocks);
}
```

```cpp
#include <hip/hip_runtime.h>
#include <hip/hip_bf16.h>
#include <hip/hip_cooperative_groups.h>
#include <cstdio>
#include <cstdint>
namespace cg = cooperative_groups;

#define DEVI __device__ __forceinline__
typedef unsigned short u16;
typedef __attribute__((ext_vector_type(8))) short bf16x8;
typedef __attribute__((ext_vector_type(4))) short s16x4;
typedef __attribute__((ext_vector_type(16))) float f32x16;
typedef __attribute__((ext_vector_type(4))) float f32x4;
typedef __attribute__((ext_vector_type(4))) unsigned u32x4;
typedef __attribute__((ext_vector_type(2))) unsigned u32x2;

constexpr int DM = 1024, NBATCH = 8, SEQ = 8192, CTXL = 256, ROWS = SEQ + CTXL;
constexpr int NF = 9728;
constexpr int F_GQ = 0, F_GK = 512, F_GV = 1024, F_GR = 2048, F_DQ = 3072, F_DK = 4096, F_DV = 5120, F_MQ = 6144, F_MKV = 6400,
              F_GATE = 6528, F_KR = 9600, F_GA = 9664;
constexpr int FH = 2816;
constexpr int NIN_ORIG = 9696;
constexpr float ALPHA = 1.4142135623730951f;
constexpr float EPS = 1e-6f;
constexpr int NTHREADS = 512;
constexpr int NBP = 2, RP = NBP * ROWS, NPASS = NBATCH / NBP;

constexpr size_t al256(size_t x) { return (x + 255) / 256 * 256; }
constexpr size_t OFF_WIN  = 0;
constexpr size_t OFF_WUQ  = OFF_WIN  + al256((size_t)2 * NF * 1024 * 2);
constexpr size_t OFF_WUKV = OFF_WUQ  + al256((size_t)2 * 1536 * 256 * 2);
constexpr size_t OFF_WBR  = OFF_WUKV + al256((size_t)2 * 2048 * 128 * 2);
constexpr size_t OFF_WOUT = OFF_WBR  + al256((size_t)2 * 3 * 1024 * 1024 * 2);
constexpr size_t OFF_WF1  = OFF_WOUT + al256((size_t)2 * 1024 * 1024 * 2);
constexpr size_t OFF_WF2  = OFF_WF1  + al256((size_t)2 * 5632 * 1024 * 2);
constexpr size_t OFF_MODV = OFF_WF2  + al256((size_t)2 * 1024 * 2816 * 2);
constexpr size_t OFF_ROPE = OFF_MODV + al256((size_t)2 * 9 * 6144 * 4);
constexpr size_t OFF_CTR  = OFF_ROPE + al256((size_t)SEQ * 64 * 4);
constexpr size_t OFF_XC   = OFF_CTR  + 2048;
constexpr size_t OFF_H    = OFF_XC   + al256((size_t)NBP * CTXL * 1024 * 4);
constexpr size_t OFF_FEAT = OFF_H    + al256((size_t)RP * 1024 * 2);
constexpr size_t OFF_QM   = OFF_FEAT + al256((size_t)RP * NF * 2);
constexpr size_t OFF_KV   = OFF_QM   + al256((size_t)RP * 1536 * 2);
constexpr size_t OFF_OG   = OFF_KV   + al256((size_t)RP * 2048 * 2);
constexpr size_t OFF_OD   = OFF_OG   + al256((size_t)2 * RP * 1024 * 2);
constexpr size_t OFF_YC   = OFF_OD   + al256((size_t)2 * RP * 1024 * 2);
constexpr size_t WS_END   = OFF_YC   + al256((size_t)RP * 1024 * 2);
constexpr size_t OFF_YA   = OFF_OG;
constexpr size_t OFF_YB   = OFF_OD;
constexpr size_t OFF_Y    = OFF_H;
constexpr size_t OFF_HID  = OFF_FEAT;

constexpr int LDS_BYTES = 140 * 1024;

struct Params {
  const float *x, *c, *ctx, *c_ctx, *w_mod, *b_mod, *w_in, *gla_w_a2, *gla_b_a, *gla_norm_g, *diff_lam, *diff_norm_g,
      *mla_q_norm_g, *mla_kv_norm_g, *mla_w_uq, *mla_w_ukv, *w_branch, *w_out, *ln1_g, *ln1_b, *ffn_w_in, *ffn_w_out, *ln2_g, *ln2_b;
  float* out;
  char* ws;
};

typedef float f32x2_t __attribute__((ext_vector_type(2)));
typedef __bf16 bf16x2_t __attribute__((ext_vector_type(2)));
DEVI unsigned cvtpk(float lo, float hi) { f32x2_t v = {lo, hi}; bf16x2_t b = __builtin_convertvector(v, bf16x2_t); return __builtin_bit_cast(unsigned, b); }
DEVI u16 f2bf(float f) { return (u16)(cvtpk(f, 0.f) & 0xffffu); }
DEVI float bf2f(u16 h) { return __uint_as_float(((unsigned)h) << 16); }
DEVI float bflo(unsigned w) { return __uint_as_float(w << 16); }
DEVI float bfhi(unsigned w) { return __uint_as_float(w & 0xffff0000u); }
DEVI void st4bf(u16* p, float a, float b, float c, float d) { u32x2 w = {cvtpk(a, b), cvtpk(c, d)}; *(u32x2*)p = w; }
DEVI float wave_sum(float v) {
#pragma unroll
  for (int m = 32; m >= 1; m >>= 1) v += __shfl_xor(v, m);
  return v;
}
DEVI float siluf(float x) { return x / (1.f + expf(-x)); }
DEVI float sigmf(float x) { return 1.f / (1.f + expf(-x)); }
DEVI int crow(int r, int hi) { return (r & 3) + 8 * (r >> 2) + 4 * hi; }
#define SBAR() __builtin_amdgcn_sched_barrier(0)

DEVI int vblock() { return (int)(blockIdx.x & 7) * (int)(gridDim.x >> 3) + (int)(blockIdx.x >> 3); }
DEVI void tile_map(int t, int NTM, int NTN, int& tm, int& tn) {
  const int per = NTM * 4, g = t / per, r = t - g * per;
  const int w = (NTN - g * 4) < 4 ? (NTN - g * 4) : 4;
  tm = r / w; tn = g * 4 + (r - tm * w);
}
DEVI int otid() { int t = threadIdx.x; asm volatile("" : "+v"(t)); return t; }

template <int MI, int NC>
DEVI void mfma_tile(f32x16 (&acc)[2 * NC][MI], const char* Ab, const char* Bb, int rowa0, int rowb0, int sa, int sb, int hi) {
  if constexpr (MI * NC >= 4) {
#pragma unroll
    for (int k16 = 0; k16 < 4; ++k16) {
      const int chn = k16 * 2 + hi;
      bf16x8 ga[2 * NC], gb[MI];
#pragma unroll
      for (int ni = 0; ni < 2 * NC; ++ni) ga[ni] = *(const bf16x8*)(Bb + (rowa0 + 32 * ni) * 128 + ((chn ^ sa) << 4));
#pragma unroll
      for (int mi = 0; mi < MI; ++mi) gb[mi] = *(const bf16x8*)(Ab + (rowb0 + 32 * mi) * 128 + ((chn ^ sb) << 4));
#pragma unroll
      for (int ni = 0; ni < 2 * NC; ++ni)
#pragma unroll
        for (int mi = 0; mi < MI; ++mi)
          acc[ni][mi] = __builtin_amdgcn_mfma_f32_32x32x16_bf16(ga[ni], gb[mi], acc[ni][mi], 0, 0, 0);
    }
    return;
  }
  bf16x8 fa[2][2 * NC], fb[2][MI];
#pragma unroll
  for (int ni = 0; ni < 2 * NC; ++ni) fa[0][ni] = *(const bf16x8*)(Bb + (rowa0 + 32 * ni) * 128 + ((hi ^ sa) << 4));
#pragma unroll
  for (int mi = 0; mi < MI; ++mi) fb[0][mi] = *(const bf16x8*)(Ab + (rowb0 + 32 * mi) * 128 + ((hi ^ sb) << 4));
#pragma unroll
  for (int k16 = 0; k16 < 4; ++k16) {
    if (k16 < 3) {
      const int chn = (k16 + 1) * 2 + hi;
#pragma unroll
      for (int ni = 0; ni < 2 * NC; ++ni) fa[(k16 + 1) & 1][ni] = *(const bf16x8*)(Bb + (rowa0 + 32 * ni) * 128 + ((chn ^ sa) << 4));
#pragma unroll
      for (int mi = 0; mi < MI; ++mi) fb[(k16 + 1) & 1][mi] = *(const bf16x8*)(Ab + (rowb0 + 32 * mi) * 128 + ((chn ^ sb) << 4));
    }
    SBAR();
#pragma unroll
    for (int ni = 0; ni < 2 * NC; ++ni)
#pragma unroll
      for (int mi = 0; mi < MI; ++mi)
        acc[ni][mi] = __builtin_amdgcn_mfma_f32_32x32x16_bf16(fa[k16 & 1][ni], fb[k16 & 1][mi], acc[ni][mi], 0, 0, 0);
    SBAR();
  }
}

template <int MI, int NC>
DEVI void gemm_kloop(f32x16 (&acc)[2 * NC][MI], const u16* __restrict__ A, long lda, const u16* __restrict__ Bt, long ldb, int K, char* lds) {
  const int tid = otid(), wid = tid >> 6, lane = tid & 63, r32 = lane & 31, hi = lane >> 5;
  const int wm = wid & 3, wn = wid >> 2;
  constexpr int ABUF = 32768, BBUF = 16384 * NC;
  char* As = lds; char* Bs = lds + 65536;
  const int ch = tid & 7, rw = tid >> 3;
  const int swz = ((ch ^ ((rw >> 1) & 7)) << 4);
  u32x4 ra[2 * MI], rb[2 * NC];
  const u16* Ap = A + (long)rw * lda + ch * 8;
  const u16* Bp = Bt + (long)rw * ldb + ch * 8;
#define GLOAD(k0) do { _Pragma("unroll") for (int i_ = 0; i_ < 2 * MI; ++i_) ra[i_] = *(const u32x4*)(Ap + (long)(64 * i_) * lda + (k0)); \
    _Pragma("unroll") for (int i_ = 0; i_ < 2 * NC; ++i_) rb[i_] = *(const u32x4*)(Bp + (long)(64 * i_) * ldb + (k0)); } while (0)
#define GWRITE(buf) do { char* a_ = As + (buf) * ABUF + rw * 128 + swz; char* b_ = Bs + (buf) * BBUF + rw * 128 + swz; \
    _Pragma("unroll") for (int i_ = 0; i_ < 2 * MI; ++i_) *(u32x4*)(a_ + i_ * 64 * 128) = ra[i_]; \
    _Pragma("unroll") for (int i_ = 0; i_ < 2 * NC; ++i_) *(u32x4*)(b_ + i_ * 64 * 128) = rb[i_]; } while (0)
#pragma unroll
  for (int i = 0; i < 2 * NC; ++i)
#pragma unroll
    for (int j = 0; j < MI; ++j)
#pragma unroll
      for (int r = 0; r < 16; ++r) acc[i][j][r] = 0.f;
  const int KT = K >> 6;
  const int grp = __builtin_amdgcn_readfirstlane(wid) >> 2;
  const int rowa0 = wn * (64 * NC) + r32, rowb0 = wm * (32 * MI) + r32;
  const int sa = (rowa0 >> 1) & 7, sb = (rowb0 >> 1) & 7;
#define MFMA_ALL(kt_) mfma_tile<MI, NC>(acc, As + ((kt_) & 1) * ABUF, Bs + ((kt_) & 1) * BBUF, rowa0, rowb0, sa, sb, hi)
#define KBAR() do { asm volatile("s_waitcnt lgkmcnt(0)" ::: "memory"); __builtin_amdgcn_s_barrier(); asm volatile("" ::: "memory"); } while (0)
  GLOAD(0); GWRITE(0); SBAR();
  if (KT > 1) GLOAD(64);
  KBAR();
  if (grp == 0) {
    for (int kt = 0; kt < KT; ++kt) {
      MFMA_ALL(kt);
      KBAR();
      if (kt + 1 < KT) { GWRITE((kt + 1) & 1); if (kt + 2 < KT) GLOAD((kt + 2) * 64); }
      KBAR();
    }
  } else {
    for (int kt = 0; kt < KT; ++kt) {
      if (kt + 1 < KT) { GWRITE((kt + 1) & 1); if (kt + 2 < KT) GLOAD((kt + 2) * 64); }
      KBAR();
      MFMA_ALL(kt);
      KBAR();
    }
  }
#undef KBAR
#undef MFMA_ALL
#undef GLOAD
#undef GWRITE
}

DEVI int map_col(int mode, int n) {
  if (mode == 0) return n;
  if (mode == 1) {
    if (n < 3072) return n;
    if (n < 6528) return n + 32;
    if (n < 9600) return n + 96;
    if (n < 9664) return 6560 + (n - 9600);
    if (n < 9696) return 3072 + (n - 9664);
    return -1;
  }
  const int grp = n >> 6, w = n & 63;
  return (w < 32) ? (grp * 32 + w) : (FH + grp * 32 + (w - 32));
}
DEVI void conv_weight(const float* __restrict__ src, int ldsrc, u16* __restrict__ dst, int Ndst, int K, int mode, const float* __restrict__ kscale, char* lds) {
  float* t = (float*)lds;
  const int tid = otid();
  const int ntn = Ndst >> 6, ntk = K >> 6;
  for (int tile = blockIdx.x; tile < ntn * ntk; tile += gridDim.x) {
    const int n0 = (tile / ntk) << 6, k0 = (tile % ntk) << 6;
    __syncthreads();
#pragma unroll
    for (int it = 0; it < 2; ++it) {
      const int idx = tid + it * NTHREADS, kk = idx >> 4, n4 = (idx & 15) * 4;
      const int sc = map_col(mode, n0 + n4);
      f32x4 v = {0.f, 0.f, 0.f, 0.f};
      if (sc >= 0) v = *(const f32x4*)(src + (long)(k0 + kk) * ldsrc + sc);
      if (kscale) { const float ks = kscale[k0 + kk]; v[0] *= ks; v[1] *= ks; v[2] *= ks; v[3] *= ks; }
      t[(n4 + 0) * 68 + kk] = v[0]; t[(n4 + 1) * 68 + kk] = v[1]; t[(n4 + 2) * 68 + kk] = v[2]; t[(n4 + 3) * 68 + kk] = v[3];
    }
    __syncthreads();
    {
      const int nn = tid >> 3, k8 = (tid & 7) * 8;
      const f32x4 a = *(const f32x4*)(t + nn * 68 + k8), c = *(const f32x4*)(t + nn * 68 + k8 + 4);
      u32x4 w = {cvtpk(a[0], a[1]), cvtpk(a[2], a[3]), cvtpk(c[0], c[1]), cvtpk(c[2], c[3])};
      *(u32x4*)(dst + (long)(n0 + nn) * K + k0 + k8) = w;
    }
  }
  __syncthreads();
}

DEVI void phase_modv(const Params& p, char* lds) {
  float* ca = (float*)lds;
  float* red = ca + 9 * 1024;
  float* modv = (float*)(p.ws + OFF_MODV);
  const int tid = otid();
  __syncthreads();
  for (int i = tid; i < 9 * 1024; i += NTHREADS) {
    const float v = (i < 8192) ? p.c[i] : p.c_ctx[i - 8192];
    ca[i] = siluf(v);
  }
  __syncthreads();
  const int col = tid & 63, ks = tid >> 6;
  for (int tile = blockIdx.x; tile < 2 * 96; tile += gridDim.x) {
    const int l = tile / 96, n0 = (tile % 96) * 64;
    const float* W = p.w_mod + (long)l * 1024 * 6144 + n0 + col;
    float a[9];
#pragma unroll
    for (int j = 0; j < 9; ++j) a[j] = 0.f;
    for (int k = ks * 128; k < ks * 128 + 128; ++k) {
      const float w = W[(long)k * 6144];
#pragma unroll
      for (int j = 0; j < 9; ++j) a[j] += ca[j * 1024 + k] * w;
    }
#pragma unroll
    for (int j = 0; j < 9; ++j) red[(ks * 64 + col) * 9 + j] = a[j];
    __syncthreads();
    for (int i = tid; i < 64 * 9; i += NTHREADS) {
      const int cc = i / 9, j = i % 9;
      float s = 0.f;
      for (int q = 0; q < 8; ++q) s += red[(q * 64 + cc) * 9 + j];
      modv[((long)l * 9 + j) * 6144 + n0 + cc] = s + p.b_mod[l * 6144 + n0 + cc];
    }
    __syncthreads();
  }
}

DEVI void phase_rope(const Params& p) {
  float* rope = (float*)(p.ws + OFF_ROPE);
  for (int i = blockIdx.x * NTHREADS + otid(); i < SEQ * 32; i += gridDim.x * NTHREADS) {
    const int t = i >> 5, f = i & 31;
    const float inv = powf(10000.f, -(float)(f & 15) / 16.f);
    const float pos = (f < 16) ? (float)(t >> 6) : (float)(t & 63);
    const float ang = pos * inv;
    rope[t * 64 + f] = cosf(ang);
    rope[t * 64 + 32 + f] = sinf(ang);
  }
}

DEVI void ln_stats(const float (&v)[16], float& mu, float& rstd) {
  float s = 0.f;
#pragma unroll
  for (int i = 0; i < 16; ++i) s += v[i];
  mu = wave_sum(s) * (1.f / 1024.f);
  float q = 0.f;
#pragma unroll
  for (int i = 0; i < 16; ++i) { const float d = v[i] - mu; q += d * d; }
  rstd = rsqrtf(wave_sum(q) * (1.f / 1024.f) + EPS);
}
DEVI void rowload(const float* __restrict__ src, float (&v)[16]) {
  const int lane = otid() & 63;
#pragma unroll
  for (int i = 0; i < 4; ++i) {
    const f32x4 t = *(const f32x4*)(src + i * 256 + lane * 4);
    v[i * 4 + 0] = t[0]; v[i * 4 + 1] = t[1]; v[i * 4 + 2] = t[2]; v[i * 4 + 3] = t[3];
  }
}
DEVI void rowproc(float (&v)[16], float* __restrict__ dst, const float* __restrict__ ag, const float* __restrict__ ab,
                  u16* __restrict__ hout, const float* __restrict__ sh, const float* __restrict__ sc) {
  const int lane = otid() & 63;
  float mu, rstd;
  if (ag) {
    ln_stats(v, mu, rstd);
#pragma unroll
    for (int i = 0; i < 4; ++i) {
      const f32x4 g = *(const f32x4*)(ag + i * 256 + lane * 4);
      const f32x4 b = *(const f32x4*)(ab + i * 256 + lane * 4);
      f32x4 o;
#pragma unroll
      for (int j = 0; j < 4; ++j) { v[i * 4 + j] = (v[i * 4 + j] - mu) * rstd * g[j] + b[j]; o[j] = v[i * 4 + j]; }
      *(f32x4*)(dst + i * 256 + lane * 4) = o;
    }
  }
  if (hout) {
    ln_stats(v, mu, rstd);
#pragma unroll
    for (int i = 0; i < 4; ++i) {
      const f32x4 s1 = *(const f32x4*)(sc + i * 256 + lane * 4);
      const f32x4 s0 = *(const f32x4*)(sh + i * 256 + lane * 4);
      float h[4];
#pragma unroll
      for (int j = 0; j < 4; ++j) h[j] = (v[i * 4 + j] - mu) * rstd * (1.f + s1[j]) + s0[j];
      st4bf(hout + i * 256 + lane * 4, h[0], h[1], h[2], h[3]);
    }
  }
}
DEVI int rr_of(int r) { return r >= ROWS ? r - ROWS : r; }
DEVI int bi_of(int r) { return r >= ROWS ? 1 : 0; }
DEVI const float* modvec(const Params& p, int l, int ps, int r, int which) {
  const float* modv = (const float*)(p.ws + OFF_MODV);
  const int j = (rr_of(r) < SEQ) ? (ps * NBP + bi_of(r)) : 8;
  return modv + ((long)l * 9 + j) * 6144 + which * 1024;
}
DEVI const float* inrow(const Params& p, int ps, int r) {
  const int b = ps * NBP + bi_of(r), rr = rr_of(r);
  return (rr < SEQ) ? (p.x + ((long)b * SEQ + rr) * 1024) : (p.ctx + ((long)b * CTXL + (rr - SEQ)) * 1024);
}
DEVI float* xrow(const Params& p, int ps, int r) {
  const int b = ps * NBP + bi_of(r), rr = rr_of(r);
  return (rr < SEQ) ? (p.out + ((long)b * SEQ + rr) * 1024) : ((float*)(p.ws + OFF_XC) + (long)(bi_of(r) * CTXL + rr - SEQ) * 1024);
}
DEVI int row_next(int r, int nw, bool skipctx) { while (r < RP && skipctx && rr_of(r) >= SEQ) r += nw; return r; }
DEVI void row_loop(const Params& p, int ps, int l, int kind) {
  const int gw = blockIdx.x * 8 + (otid() >> 6), nw = gridDim.x * 8;
  const bool skipctx = (kind == 1 && l == 1) || kind == 3;
  u16* Hb = (u16*)(p.ws + OFF_H);
  float v[16], vn[16];
  int r = row_next(gw, nw, skipctx);
  if (r < RP) rowload(kind == 0 ? inrow(p, ps, r) : xrow(p, ps, r), v);
  while (r < RP) {
    const int rn = row_next(r + nw, nw, skipctx);
    if (rn < RP) rowload(kind == 0 ? inrow(p, ps, rn) : xrow(p, ps, rn), vn);
    float* xr = xrow(p, ps, r);
    u16* hrow = Hb + (long)r * 1024;
    if (kind == 0)      rowproc(v, nullptr, nullptr, nullptr, hrow, modvec(p, 0, ps, r, 0), modvec(p, 0, ps, r, 1));
    else if (kind == 1) rowproc(v, xr, p.ln1_g + l * 1024, p.ln1_b + l * 1024, hrow, modvec(p, l, ps, r, 3), modvec(p, l, ps, r, 4));
    else if (kind == 2) rowproc(v, xr, p.ln2_g, p.ln2_b, hrow, modvec(p, 1, ps, r, 0), modvec(p, 1, ps, r, 1));
    else                rowproc(v, xr, p.ln2_g + 1024, p.ln2_b + 1024, nullptr, nullptr, nullptr);
#pragma unroll
    for (int i = 0; i < 16; ++i) v[i] = vn[i];
    r = rn;
  }
}
DEVI void phase_mod1_l0(const Params& p, int ps) { row_loop(p, ps, 0, 0); }
DEVI void phase_rows_a(const Params& p, int ps, int l) { row_loop(p, ps, l, 1); }
DEVI void phase_rows_b(const Params& p, int ps, int l) {
  if (l == 0) row_loop(p, ps, 0, 2);
  else { row_loop(p, ps, 1, 3); if (ps + 1 < NPASS) row_loop(p, ps + 1, 0, 0); }
}
DEVI int tile_m0(int tm, int l, int TR) { const int tpb = (l == 0 ? ROWS : SEQ) / TR; return (tm / tpb) * ROWS + (tm % tpb) * TR; }
DEVI int tile_ntm(int l, int TR) { return NBP * ((l == 0 ? ROWS : SEQ) / TR); }

template <int NCOLS> DEVI void wave_tile_store(const char* wl, u16* gbase, long ld, int lane) {
  constexpr int RS = NCOLS * 2 + 16, CPR = NCOLS / 8, RPI = 64 / CPR;
  const int rsub = lane / CPR, chk = lane % CPR;
  SBAR();
#pragma unroll 4
  for (int it = 0; it < 64 / RPI; ++it) {
    const int row = it * RPI + rsub;
    const u32x4 v = *(const u32x4*)(wl + row * RS + chk * 16);
    __builtin_nontemporal_store(v, (u32x4*)(gbase + (long)row * ld + chk * 8));
  }
}
DEVI void lds_put4(char* wl, int RS, int row, int col, float a, float b, float c, float d) { u32x2 w = {cvtpk(a, b), cvtpk(c, d)}; *(u32x2*)(wl + row * RS + col * 2) = w; }

DEVI void phase_gemm_in(const Params& p, int l, char* lds) {
  const u16* H = (const u16*)(p.ws + OFF_H);
  const u16* W = (const u16*)(p.ws + OFF_WIN) + (long)l * NF * 1024;
  u16* feat = (u16*)(p.ws + OFF_FEAT);
  const float* rope = (const float*)(p.ws + OFF_ROPE);
  const int lane = otid() & 63, wid = otid() >> 6, r32 = lane & 31, hi = lane >> 5, wm = wid & 3, wn = wid >> 2;
  constexpr int NTN = NF / 256, NTM = RP / 256;
  for (int tile = vblock(); tile < NTN * NTM; tile += gridDim.x) {
    int tm, tn; tile_map(tile, NTM, NTN, tm, tn);
    const int m0 = tm * 256, n0 = tn * 256;
    f32x16 acc[4][2];
    __syncthreads();
    gemm_kloop<2, 2>(acc, H + (long)m0 * 1024, 1024, W + (long)n0 * 1024, 1024, 1024, lds);
    SBAR();
    char* wl = lds + wid * (64 * 272);
#pragma unroll
    for (int cg2 = 0; cg2 < 2; ++cg2) {
      SBAR();
      const int cb = n0 + wn * 128 + cg2 * 64;
      int mode = 0;
      if (cb < F_GK) mode = 1;
      else if ((cb >= F_DQ && cb < F_DV) || cb == F_KR) mode = 2;
      else if (cb >= F_GATE && cb < F_KR) mode = 3;
#pragma unroll
      for (int mi = 0; mi < 2; ++mi) {
        const int m = m0 + wm * 64 + mi * 32 + r32;
#pragma unroll
        for (int q = 0; q < 4; ++q) {
          const int ci = q * 8 + hi * 4;
          float x1[4], x2[4];
#pragma unroll
          for (int j = 0; j < 4; ++j) { x1[j] = acc[2 * cg2][mi][q * 4 + j]; x2[j] = acc[2 * cg2 + 1][mi][q * 4 + j]; }
          if (mode == 1) {
#pragma unroll
            for (int j = 0; j < 4; ++j) { x1[j] *= 0.08838834764831845f; x2[j] *= 0.08838834764831845f; }
          } else if (mode == 2) {
            if (rr_of(m) < SEQ) {
              const f32x4 cs = *(const f32x4*)(rope + (long)rr_of(m) * 64 + ci);
              const f32x4 sn = *(const f32x4*)(rope + (long)rr_of(m) * 64 + 32 + ci);
#pragma unroll
              for (int j = 0; j < 4; ++j) { const float a = x1[j], bb = x2[j]; x1[j] = a * cs[j] - bb * sn[j]; x2[j] = a * sn[j] + bb * cs[j]; }
            }
          } else if (mode == 3) {
#pragma unroll
            for (int j = 0; j < 4; ++j) { x1[j] = sigmf(x1[j]); x2[j] = sigmf(x2[j]); }
          }
          lds_put4(wl, 272, mi * 32 + r32, cg2 * 64 + ci, x1[0], x1[1], x1[2], x1[3]);
          lds_put4(wl, 272, mi * 32 + r32, cg2 * 64 + 32 + ci, x2[0], x2[1], x2[2], x2[3]);
        }
      }
    }
    wave_tile_store<128>(wl, feat + (long)(m0 + wm * 64) * NF + n0 + wn * 128, NF, lane);
  }
}

DEVI void phase_gemm_up(const Params& p, int l, char* lds) {
  const u16* feat = (const u16*)(p.ws + OFF_FEAT);
  const float* rope = (const float*)(p.ws + OFF_ROPE);
  float* rs = (float*)(lds + 98304);
  const int tid = otid(), lane = tid & 63, wid = tid >> 6, r32 = lane & 31, hi = lane >> 5, wm = wid & 3, wn = wid >> 2;
  constexpr int NTM = RP / 256, NQ = 12, NK = 16;
  for (int tile = vblock(); tile < NTM * (NQ + NK); tile += gridDim.x) {
    int tm, tn; tile_map(tile, NTM, NQ + NK, tm, tn);
    const bool isq = tn < NQ;
    const int m0 = tm * 256, n0 = (isq ? tn : tn - NQ) * 128;
    const int K = isq ? 256 : 128;
    const u16* A = feat + (long)m0 * NF + (isq ? F_MQ : F_MKV);
    const u16* W = isq ? ((const u16*)(p.ws + OFF_WUQ) + (long)l * 1536 * 256 + (long)n0 * 256)
                       : ((const u16*)(p.ws + OFF_WUKV) + (long)l * 2048 * 128 + (long)n0 * 128);
    __syncthreads();
    {
      const int row = tid >> 1, half = tid & 1, n8 = K / 16;
      const u16* ap = A + (long)row * NF + half * (K / 2);
      float ss = 0.f;
      for (int i = 0; i < n8; ++i) {
        const u32x4 w = *(const u32x4*)(ap + i * 8);
#pragma unroll
        for (int j = 0; j < 4; ++j) { const float a = bflo(w[j]), b = bfhi(w[j]); ss += a * a + b * b; }
      }
      ss += __shfl_xor(ss, 1);
      if (half == 0) rs[row] = rsqrtf(ss / (float)K + EPS);
    }
    f32x16 acc[2][2];
    gemm_kloop<2, 1>(acc, A, NF, W, K, K, lds);
    const int cb = n0 + wn * 64;
    const bool dorope = isq && ((cb % 192) == 128);
    u16* outp = isq ? (u16*)(p.ws + OFF_QM) : (u16*)(p.ws + OFF_KV);
    const int ldo = isq ? 1536 : 2048;
    char* wl = lds + wid * (64 * 144);
#pragma unroll
    for (int mi = 0; mi < 2; ++mi) {
      const int ml = wm * 64 + mi * 32 + r32, m = m0 + ml;
      const float sc = rs[ml];
#pragma unroll
      for (int q = 0; q < 4; ++q) {
        const int ci = q * 8 + hi * 4;
        float x1[4], x2[4];
#pragma unroll
        for (int j = 0; j < 4; ++j) { x1[j] = acc[0][mi][q * 4 + j] * sc; x2[j] = acc[1][mi][q * 4 + j] * sc; }
        if (dorope && rr_of(m) < SEQ) {
          const f32x4 cs = *(const f32x4*)(rope + (long)rr_of(m) * 64 + ci);
          const f32x4 sn = *(const f32x4*)(rope + (long)rr_of(m) * 64 + 32 + ci);
#pragma unroll
          for (int j = 0; j < 4; ++j) { const float a = x1[j], bb = x2[j]; x1[j] = a * cs[j] - bb * sn[j]; x2[j] = a * sn[j] + bb * cs[j]; }
        }
        lds_put4(wl, 144, mi * 32 + r32, ci, x1[0], x1[1], x1[2], x1[3]);
        lds_put4(wl, 144, mi * 32 + r32, 32 + ci, x2[0], x2[1], x2[2], x2[3]);
      }
    }
    wave_tile_store<64>(wl, outp + (long)(m0 + wm * 64) * ldo + cb, ldo, lane);
  }
}

DEVI void phase_gemm_br(const Params& p, int l, char* lds) {
  const u16* feat = (const u16*)(p.ws + OFF_FEAT);
  u16* Y = (u16*)(p.ws + OFF_Y);
  const int lane = otid() & 63, wid = otid() >> 6, r32 = lane & 31, hi = lane >> 5, wm = wid & 3, wn = wid >> 2;
  const int NTM = tile_ntm(l, 128);
  for (int tile = vblock(); tile < NTM * 8; tile += gridDim.x) {
    int tm, tn; tile_map(tile, NTM, 8, tm, tn);
    const int m0 = tile_m0(tm, l, 128), n0 = tn * 128;
    const int m = m0 + wm * 32 + r32;
    f32x16 tot[2];
#pragma unroll
    for (int i = 0; i < 3; ++i) {
      const u16* A = (const u16*)(p.ws + (i == 0 ? OFF_YA : (i == 1 ? OFF_YB : OFF_YC))) + (long)m0 * 1024;
      const u16* W = (const u16*)(p.ws + OFF_WBR) + ((long)(l * 3 + i) * 1024 + n0) * 1024;
      f32x16 acc[2][1];
      gemm_kloop<1, 1>(acc, A, 1024, W, 1024, 1024, lds);
#pragma unroll
      for (int ni = 0; ni < 2; ++ni)
#pragma unroll
        for (int q = 0; q < 4; ++q) {
          const int n = n0 + wn * 64 + ni * 32 + q * 8 + hi * 4;
          const u32x2 g = *(const u32x2*)(feat + (long)m * NF + F_GATE + i * 1024 + n);
          const float g0 = bflo(g[0]), g1 = bfhi(g[0]), g2 = bflo(g[1]), g3 = bfhi(g[1]);
          if (i == 0) {
            tot[ni][q * 4 + 0] = g0 * acc[ni][0][q * 4 + 0]; tot[ni][q * 4 + 1] = g1 * acc[ni][0][q * 4 + 1];
            tot[ni][q * 4 + 2] = g2 * acc[ni][0][q * 4 + 2]; tot[ni][q * 4 + 3] = g3 * acc[ni][0][q * 4 + 3];
          } else {
            tot[ni][q * 4 + 0] += g0 * acc[ni][0][q * 4 + 0]; tot[ni][q * 4 + 1] += g1 * acc[ni][0][q * 4 + 1];
            tot[ni][q * 4 + 2] += g2 * acc[ni][0][q * 4 + 2]; tot[ni][q * 4 + 3] += g3 * acc[ni][0][q * 4 + 3];
          }
        }
    }
#pragma unroll
    for (int ni = 0; ni < 2; ++ni)
#pragma unroll
      for (int q = 0; q < 4; ++q) {
        const int n = n0 + wn * 64 + ni * 32 + q * 8 + hi * 4;
        st4bf(Y + (long)m * 1024 + n, tot[ni][q * 4 + 0], tot[ni][q * 4 + 1], tot[ni][q * 4 + 2], tot[ni][q * 4 + 3]);
      }
  }
}

DEVI void phase_gemm_res(const Params& p, int ps, int l, int which, char* lds) {
  const int lane = otid() & 63, wid = otid() >> 6, r32 = lane & 31, hi = lane >> 5, wm = wid & 3, wn = wid >> 2;
  const int NTM = tile_ntm(l, 128);
  const bool first = (which == 2);
  const int K = first ? 1024 : FH;
  const u16* Abase = first ? (const u16*)(p.ws + OFF_Y) : (const u16*)(p.ws + OFF_HID);
  const u16* Wbase = first ? ((const u16*)(p.ws + OFF_WOUT) + (long)l * 1024 * 1024) : ((const u16*)(p.ws + OFF_WF2) + (long)l * 1024 * FH);
  for (int tile = vblock(); tile < NTM * 8; tile += gridDim.x) {
    int tm, tn; tile_map(tile, NTM, 8, tm, tn);
    const int m0 = tile_m0(tm, l, 128), n0 = tn * 128;
    f32x16 acc[2][1];
    gemm_kloop<1, 1>(acc, Abase + (long)m0 * K, K, Wbase + (long)n0 * K, K, K, lds);
    const int m = m0 + wm * 32 + r32;
    const float* gv = modvec(p, l, ps, m, which);
    float* dst = xrow(p, ps, m);
    const float* xin = dst;
    if (first && l == 0) xin = inrow(p, ps, m);
#pragma unroll
    for (int ni = 0; ni < 2; ++ni)
#pragma unroll
      for (int q = 0; q < 4; ++q) {
        const int n = n0 + wn * 64 + ni * 32 + q * 8 + hi * 4;
        const f32x4 xi = *(const f32x4*)(xin + n);
        const f32x4 g = *(const f32x4*)(gv + n);
        f32x4 o;
#pragma unroll
        for (int j = 0; j < 4; ++j) o[j] = ALPHA * xi[j] + g[j] * acc[ni][0][q * 4 + j];
        *(f32x4*)(dst + n) = o;
      }
  }
}

DEVI void phase_gemm_f1(const Params& p, int l, char* lds) {
  const u16* H = (const u16*)(p.ws + OFF_H);
  const u16* W = (const u16*)(p.ws + OFF_WF1) + (long)l * 5632 * 1024;
  u16* hid = (u16*)(p.ws + OFF_HID);
  const int lane = otid() & 63, wid = otid() >> 6, r32 = lane & 31, hi = lane >> 5, wm = wid & 3, wn = wid >> 2;
  const int NTM = tile_ntm(l, 256);
  for (int tile = vblock(); tile < NTM * 22; tile += gridDim.x) {
    int tm, tn; tile_map(tile, NTM, 22, tm, tn);
    const int m0 = tile_m0(tm, l, 256), n0 = tn * 256;
    f32x16 acc[4][2];
    __syncthreads();
    gemm_kloop<2, 2>(acc, H + (long)m0 * 1024, 1024, W + (long)n0 * 1024, 1024, 1024, lds);
    char* wl = lds + wid * (64 * 144);
#pragma unroll
    for (int cg2 = 0; cg2 < 2; ++cg2) {
#pragma unroll
      for (int mi = 0; mi < 2; ++mi) {
#pragma unroll
        for (int q = 0; q < 4; ++q) {
          float h[4];
#pragma unroll
          for (int j = 0; j < 4; ++j) h[j] = siluf(acc[2 * cg2][mi][q * 4 + j]) * acc[2 * cg2 + 1][mi][q * 4 + j];
          lds_put4(wl, 144, mi * 32 + r32, cg2 * 32 + q * 8 + hi * 4, h[0], h[1], h[2], h[3]);
        }
      }
    }
    wave_tile_store<64>(wl, hid + (long)(m0 + wm * 64) * FH + (tn * 4 + wn * 2) * 32, FH, lane);
  }
}

DEVI void phase_prep(const Params& p, int l) {
  const int lane = otid() & 63;
  const int gw = blockIdx.x * 8 + (otid() >> 6), nw = gridDim.x * 8;
  const float lam_init = 0.8f - 0.6f * expf(-0.3f * (float)l);
  const float* dl = p.diff_lam + l * 256;
  const float s01 = wave_sum(dl[lane] * dl[64 + lane]), s23 = wave_sum(dl[128 + lane] * dl[192 + lane]);
  const float lam = expf(s01) - expf(s23) + lam_init;
  const u16* feat = (const u16*)(p.ws + OFF_FEAT);
  const u16* og0 = (const u16*)(p.ws + OFF_OG); const u16* og1 = og0 + (long)RP * 1024;
  const u16* od0 = (const u16*)(p.ws + OFF_OD); const u16* od1 = od0 + (long)RP * 1024;
  u16* ya = (u16*)(p.ws + OFF_YA); u16* yb = (u16*)(p.ws + OFF_YB);
  const f32x4 gg = *(const f32x4*)(p.gla_norm_g + l * 256 + lane * 4);
  const float dg0 = p.diff_norm_g[l * 128 + lane * 2] * (1.f - lam_init), dg1 = p.diff_norm_g[l * 128 + lane * 2 + 1] * (1.f - lam_init);
  for (int r = gw; r < RP; r += nw) {
    if (l == 1 && rr_of(r) >= SEQ) continue;
    u32x2 ga[4], gb[4], gr[4]; unsigned da[8], db[8];
#pragma unroll
    for (int u = 0; u < 4; ++u) {
      const long off = (long)r * 1024 + u * 256 + lane * 4;
      ga[u] = *(const u32x2*)(og0 + off); gb[u] = *(const u32x2*)(og1 + off);
      gr[u] = *(const u32x2*)(feat + (long)r * NF + F_GR + u * 256 + lane * 4);
    }
#pragma unroll
    for (int h = 0; h < 8; ++h) {
      const long off = (long)r * 1024 + h * 128 + lane * 2;
      da[h] = *(const unsigned*)(od0 + off); db[h] = *(const unsigned*)(od1 + off);
    }
    float o[4][4], ss[4], e0[8], e1[8], sd[8];
#pragma unroll
    for (int u = 0; u < 4; ++u) {
      o[u][0] = bflo(ga[u][0]) + bflo(gb[u][0]); o[u][1] = bfhi(ga[u][0]) + bfhi(gb[u][0]);
      o[u][2] = bflo(ga[u][1]) + bflo(gb[u][1]); o[u][3] = bfhi(ga[u][1]) + bfhi(gb[u][1]);
      ss[u] = o[u][0] * o[u][0] + o[u][1] * o[u][1] + o[u][2] * o[u][2] + o[u][3] * o[u][3];
    }
#pragma unroll
    for (int h = 0; h < 8; ++h) {
      e0[h] = bflo(da[h]) - lam * bflo(db[h]); e1[h] = bfhi(da[h]) - lam * bfhi(db[h]);
      sd[h] = e0[h] * e0[h] + e1[h] * e1[h];
    }
#pragma unroll
    for (int m = 32; m >= 1; m >>= 1) {
#pragma unroll
      for (int u = 0; u < 4; ++u) ss[u] += __shfl_xor(ss[u], m);
#pragma unroll
      for (int h = 0; h < 8; ++h) sd[h] += __shfl_xor(sd[h], m);
    }
#pragma unroll
    for (int u = 0; u < 4; ++u) {
      const float rsd = rsqrtf(ss[u] * (1.f / 256.f) + EPS);
      const float rv[4] = {bflo(gr[u][0]), bfhi(gr[u][0]), bflo(gr[u][1]), bfhi(gr[u][1])};
      float y[4];
#pragma unroll
      for (int j = 0; j < 4; ++j) y[j] = o[u][j] * rsd * gg[j] * siluf(rv[j]);
      st4bf(ya + (long)r * 1024 + u * 256 + lane * 4, y[0], y[1], y[2], y[3]);
    }
#pragma unroll
    for (int h = 0; h < 8; ++h) {
      const float rsd = rsqrtf(sd[h] * (1.f / 128.f) + EPS);
      *(unsigned*)(yb + (long)r * 1024 + h * 128 + lane * 2) = cvtpk(e0[h] * rsd * dg0, e1[h] * rsd * dg1);
    }
  }
}

DEVI int v_st(int k, int c) { const int kk = (k & ~0xC) | ((k & 4) << 1) | ((k & 8) >> 1); return ((kk >> 3) * 4 + (c >> 5)) * 512 + ((kk & 7) * 32 + (c & 31)) * 2; }
DEVI int v_rd_base(int lane) { return ((lane & 3) << 3) | (((lane >> 2) & 3) << 6) | (((lane >> 4) & 1) << 5) | (((lane >> 5) & 1) << 8); }
constexpr int v_rd_off(int d0, int ks, int half) { return d0 * 512 + ks * 4096 + half * 2048; }
template <int OFF> DEVI s16x4 tr_read(int vb) {
  s16x4 r; asm volatile("ds_read_b64_tr_b16 %0, %1 offset:%2" : "=&v"(r) : "v"(vb), "i"(OFF) : "memory"); return r;
}
template <int D0> DEVI void pv_one(f32x16& od, int vb, bf16x8 pa0, bf16x8 pa1, bf16x8 pa2, bf16x8 pa3) {
  const s16x4 l0 = tr_read<v_rd_off(D0, 0, 0)>(vb), h0 = tr_read<v_rd_off(D0, 0, 1)>(vb), l1 = tr_read<v_rd_off(D0, 1, 0)>(vb), h1 = tr_read<v_rd_off(D0, 1, 1)>(vb);
  const s16x4 l2 = tr_read<v_rd_off(D0, 2, 0)>(vb), h2 = tr_read<v_rd_off(D0, 2, 1)>(vb), l3 = tr_read<v_rd_off(D0, 3, 0)>(vb), h3 = tr_read<v_rd_off(D0, 3, 1)>(vb);
  asm volatile("s_waitcnt lgkmcnt(0)" ::: "memory"); SBAR();
#define PK(L, H) (bf16x8){L[0], L[1], L[2], L[3], H[0], H[1], H[2], H[3]}
  od = __builtin_amdgcn_mfma_f32_32x32x16_bf16(pa0, PK(l0, h0), od, 0, 0, 0);
  od = __builtin_amdgcn_mfma_f32_32x32x16_bf16(pa1, PK(l1, h1), od, 0, 0, 0);
  od = __builtin_amdgcn_mfma_f32_32x32x16_bf16(pa2, PK(l2, h2), od, 0, 0, 0);
  od = __builtin_amdgcn_mfma_f32_32x32x16_bf16(pa3, PK(l3, h3), od, 0, 0, 0);
#undef PK
}
DEVI void pv_d0(f32x16* o, int vb, bf16x8 pa0, bf16x8 pa1, bf16x8 pa2, bf16x8 pa3) {
  pv_one<0>(o[0], vb, pa0, pa1, pa2, pa3); pv_one<1>(o[1], vb, pa0, pa1, pa2, pa3); pv_one<2>(o[2], vb, pa0, pa1, pa2, pa3); pv_one<3>(o[3], vb, pa0, pa1, pa2, pa3);
}
constexpr float ATT_THR = 8.f;
DEVI void partialSM(f32x16& p0, f32x16& p1, float& m_reg, float& mn, float& alpha, float scale) {
  const float C = scale * 1.4426950408889634f;
  float pmax = p0[0];
#pragma unroll
  for (int r = 1; r < 16; ++r) pmax = fmaxf(pmax, p0[r]);
#pragma unroll
  for (int r = 0; r < 16; ++r) pmax = fmaxf(pmax, p1[r]);
  { auto rr = __builtin_amdgcn_permlane32_swap(__float_as_uint(pmax), __float_as_uint(pmax), false, false);
    pmax = fmaxf(__uint_as_float(rr[0]), __uint_as_float(rr[1])); }
  if (__builtin_expect(__all(pmax - m_reg <= ATT_THR / scale), 1)) { mn = m_reg; alpha = 1.f; }
  else { mn = fmaxf(m_reg, pmax); alpha = __builtin_amdgcn_exp2f((m_reg - mn) * C); m_reg = mn; }
  const float mnC = -mn * C;
#pragma unroll
  for (int r = 0; r < 16; ++r) p0[r] = fmaf(p0[r], C, mnC);
#pragma unroll
  for (int r = 0; r < 16; ++r) p1[r] = fmaf(p1[r], C, mnC);
#pragma unroll
  for (int r = 0; r < 16; ++r) p0[r] = __builtin_amdgcn_exp2f(p0[r]);
}
#define PK4(P, BASE, OUT) do { unsigned a0 = cvtpk(P[BASE + 0], P[BASE + 1]), a1 = cvtpk(P[BASE + 2], P[BASE + 3]);   \
    unsigned b0 = cvtpk(P[BASE + 4], P[BASE + 5]), b1 = cvtpk(P[BASE + 6], P[BASE + 7]);                              \
    auto r0 = __builtin_amdgcn_permlane32_swap(a0, b0, false, false); auto r1 = __builtin_amdgcn_permlane32_swap(a1, b1, false, false); \
    u32x4 w = {r0[0], r1[0], r0[1], r1[1]}; OUT = *reinterpret_cast<bf16x8*>(&w); } while (0)
DEVI void finishSM(f32x16& p0, f32x16& p1, float alpha, float& l_reg, bf16x8& pa0, bf16x8& pa1, bf16x8& pa2, bf16x8& pa3) {
#pragma unroll
  for (int r = 0; r < 16; ++r) p1[r] = __builtin_amdgcn_exp2f(p1[r]);
  float ps = 0;
#pragma unroll
  for (int r = 0; r < 16; ++r) ps += p0[r];
#pragma unroll
  for (int r = 0; r < 16; ++r) ps += p1[r];
  { auto rr = __builtin_amdgcn_permlane32_swap(__float_as_uint(ps), __float_as_uint(ps), false, false);
    ps = __uint_as_float(rr[0]) + __uint_as_float(rr[1]); }
  l_reg = l_reg * alpha + ps;
  PK4(p0, 0, pa0); PK4(p0, 8, pa1); PK4(p1, 0, pa2); PK4(p1, 8, pa3);
}

template <int DQK, bool PIPE>
DEVI void attn_body(const u16* __restrict__ Qb, int ldq, const u16* __restrict__ K0, int ldk0, const u16* __restrict__ K1, int ldk1,
                    const u16* __restrict__ Vh, int ldv, u16* __restrict__ Ob, int ldo, int seq, float scale, char* lds) {
  constexpr int KRB = DQK * 2, SHM_K = 64 * KRB, SHM_V = 16384, ND0 = DQK / 16, NCH = DQK / 8, NKC = (64 * NCH) / NTHREADS;
  const int tid = otid(), wid = tid >> 6, lane = tid & 63, r32 = lane & 31, hi = lane >> 5;
  char* V_lds = lds; char* K_lds = lds + 2 * SHM_V;
  float* wsf = (float*)(lds + 2 * SHM_V + 2 * SHM_K) + wid * 64; float* li_l = wsf; float* al_l = wsf + 32;
  float m_reg = -1e30f, l_reg = 0; f32x16 o[4];
#pragma unroll
  for (int d = 0; d < 4; ++d)
#pragma unroll
    for (int r = 0; r < 16; ++r) o[d][r] = 0.f;
  bf16x8 qr[ND0];
  const u16* Qw = Qb + (long)(wid * 32 + r32) * ldq + hi * 8;
#pragma unroll
  for (int d0 = 0; d0 < ND0; ++d0) qr[d0] = *(const bf16x8*)(Qw + d0 * 16);
  const int sr = tid >> 4, sc = (tid & 15) * 8, vst0 = v_st(sr, sc), vst1 = v_st(32 + sr, sc);
  const int vb0 = (int)(uintptr_t)V_lds + v_rd_base(lane);
  bf16x8 vs0, vs1, ksg[NKC];
  const int krow0 = (DQK == 64) ? (tid >> 3) : (tid >> 4), kchk0 = (DQK == 64) ? (tid & 7) : (tid & 15);
  const u16* kp0 = K0 + (long)krow0 * ldk0 + kchk0 * 8;
  const int koff0 = krow0 * KRB + ((kchk0 * 16) ^ (((krow0 >> 1) & 7) << 4));
  const int koff1 = (krow0 + 32) * KRB + ((kchk0 * 16) ^ (((krow0 >> 1) & 7) << 4));
  const int krow2 = tid >> 3, kchk2 = 16 + (tid & 7);
  const u16* kp2 = K1 + (long)krow2 * ldk1 + (tid & 7) * 8;
  const int koff2 = krow2 * KRB + ((kchk2 * 16) ^ (((krow2 >> 1) & 7) << 4));
  const u16* vp0 = Vh + (long)sr * ldv + sc;
#define SLOAD(k0) do { vs0 = *(const bf16x8*)(vp0 + (long)(k0) * ldv); vs1 = *(const bf16x8*)(vp0 + (long)((k0) + 32) * ldv); \
    ksg[0] = *(const bf16x8*)(kp0 + (long)(k0) * ldk0); \
    if constexpr (DQK == 192) { ksg[1] = *(const bf16x8*)(kp0 + (long)((k0) + 32) * ldk0); ksg[2] = *(const bf16x8*)(kp2 + (long)(k0) * ldk1); } } while (0)
#define SWRITE(b) do { *(bf16x8*)(V_lds + (b) * SHM_V + vst0) = vs0; *(bf16x8*)(V_lds + (b) * SHM_V + vst1) = vs1; \
    *(bf16x8*)(K_lds + (b) * SHM_K + koff0) = ksg[0]; \
    if constexpr (DQK == 192) { *(bf16x8*)(K_lds + (b) * SHM_K + koff1) = ksg[1]; *(bf16x8*)(K_lds + (b) * SHM_K + koff2) = ksg[2]; } } while (0)
#define SWAIT() asm volatile("s_waitcnt vmcnt(0)" ::: "memory")
#define RESC(a) do { if (__any((a) < 1.f)) { if (hi == 0) al_l[r32] = (a); asm volatile("s_waitcnt lgkmcnt(0)" ::: "memory"); \
    _Pragma("unroll") for (int d = 0; d < 4; ++d) _Pragma("unroll") for (int r = 0; r < 16; ++r) o[d][r] *= al_l[crow(r, hi)]; } } while (0)
#define QKT(P0, P1, KB) do { _Pragma("unroll") for (int r_ = 0; r_ < 16; ++r_) { P0[r_] = 0.f; P1[r_] = 0.f; } \
    _Pragma("unroll") for (int d0 = 0; d0 < ND0; ++d0) { const int cb_ = (d0 * 16 + hi * 8) * 2; \
      bf16x8 b0_ = *(const bf16x8*)((KB) + r32 * KRB + (cb_ ^ (((r32 >> 1) & 7) << 4))); \
      bf16x8 b1_ = *(const bf16x8*)((KB) + (32 + r32) * KRB + (cb_ ^ (((r32 >> 1) & 7) << 4))); \
      P0 = __builtin_amdgcn_mfma_f32_32x32x16_bf16(b0_, qr[d0], P0, 0, 0, 0); \
      P1 = __builtin_amdgcn_mfma_f32_32x32x16_bf16(b1_, qr[d0], P1, 0, 0, 0); } } while (0)
  bf16x8 pa0, pa1, pa2, pa3; const int NT = seq / 64;
  if constexpr (PIPE) {
    f32x16 pA0, pA1, pB0, pB1; float mnA, mnB, alA, alB;
    SLOAD(0); SWAIT(); SWRITE(0); __syncthreads();
    QKT(pA0, pA1, K_lds); partialSM(pA0, pA1, m_reg, mnA, alA, scale);
    SLOAD(64);
    SWAIT(); SWRITE(1); __syncthreads();
    for (int j = 1; j + 1 < NT; j += 2) {
      SBAR(); QKT(pB0, pB1, K_lds + SHM_K);
      finishSM(pA0, pA1, alA, l_reg, pa0, pa1, pa2, pa3); SBAR();
      SLOAD((j + 1) * 64); SBAR();
      pv_d0(o, vb0, pa0, pa1, pa2, pa3); partialSM(pB0, pB1, m_reg, mnB, alB, scale);
      __syncthreads(); SWAIT(); SWRITE(0);
      RESC(alB); __syncthreads();
      SBAR(); QKT(pA0, pA1, K_lds);
      finishSM(pB0, pB1, alB, l_reg, pa0, pa1, pa2, pa3); SBAR();
      SLOAD((j + 2) * 64); SBAR();
      pv_d0(o, vb0 + SHM_V, pa0, pa1, pa2, pa3); partialSM(pA0, pA1, m_reg, mnA, alA, scale);
      __syncthreads(); SWAIT(); SWRITE(1);
      RESC(alA); __syncthreads();
    }
    SBAR(); QKT(pB0, pB1, K_lds + SHM_K);
    finishSM(pA0, pA1, alA, l_reg, pa0, pa1, pa2, pa3); SBAR();
    pv_d0(o, vb0, pa0, pa1, pa2, pa3); partialSM(pB0, pB1, m_reg, mnB, alB, scale);
    __syncthreads(); RESC(alB);
    finishSM(pB0, pB1, alB, l_reg, pa0, pa1, pa2, pa3); SBAR();
    pv_d0(o, vb0 + SHM_V, pa0, pa1, pa2, pa3);
  } else {
    f32x16 p0, p1; float mn, al;
    SLOAD(0); SWAIT(); SWRITE(0); __syncthreads();
    for (int j = 0; j < NT; ++j) {
      const int bsel = j & 1;
      if (j + 1 < NT) SLOAD((j + 1) * 64);
      SBAR(); QKT(p0, p1, K_lds + bsel * SHM_K);
      partialSM(p0, p1, m_reg, mn, al, scale);
      RESC(al);
      finishSM(p0, p1, al, l_reg, pa0, pa1, pa2, pa3); SBAR();
      pv_d0(o, vb0 + bsel * SHM_V, pa0, pa1, pa2, pa3);
      if (j + 1 < NT) { SWAIT(); SWRITE(bsel ^ 1); }
      __syncthreads();
    }
  }
  if (hi == 0) li_l[r32] = l_reg; asm volatile("s_waitcnt lgkmcnt(0)" ::: "memory");
  float rli[16];
#pragma unroll
  for (int r = 0; r < 16; ++r) rli[r] = __builtin_amdgcn_rcpf(li_l[crow(r, hi)]);
  u16* Ow = Ob + (long)(wid * 32) * ldo;
#pragma unroll
  for (int r = 0; r < 16; ++r) { const int orow = crow(r, hi);
#pragma unroll
    for (int d0 = 0; d0 < 4; ++d0) Ow[(long)orow * ldo + d0 * 32 + r32] = f2bf(o[d0][r] * rli[r]); }
  __syncthreads();
#undef SLOAD
#undef SWRITE
#undef SWAIT
#undef RESC
#undef QKT
}

DEVI long gla_row(int bi, int dir, int cc, int i) {
  const int L = (cc < 4) ? CTXL : SEQ, c = (cc < 4) ? cc : cc - 4, rb = bi * ROWS + ((cc < 4) ? SEQ : 0);
  const int tl = c * 64 + i;
  return (long)(rb + (dir ? (L - 1 - tl) : tl));
}
DEVI void gla_seq(const Params& p, int l, int item, char* lds) {
  const int tid = otid(), wid = tid >> 6, lane = tid & 63, r32 = lane & 31, hi = lane >> 5;
  const int bi = item >> 5, h = (item >> 3) & 3, dir = (item >> 2) & 1, sl = item & 3;
  char* qs = lds;
  char* ks = lds + 16384;
  char* kT = lds + 32768;
  char* vT = lds + 32768 + 18432;
  char* sT = lds + 32768 + 18432 + 9216;
  float* gas = (float*)(sT + 32768);
  float* segtot = gas + 1024;
  float* ebl = segtot + 512;
  const u16* feat = (const u16*)(p.ws + OFF_FEAT);
  u16* og = (u16*)(p.ws + OFF_OG) + (long)dir * RP * 1024;
  const int d = tid & 127, seg = tid >> 7;
  float w2[16];
#pragma unroll
  for (int r = 0; r < 16; ++r) w2[r] = p.gla_w_a2[(((long)l * 2 + dir) * 16 + r) * 512 + h * 128 + d];
  const float ba = p.gla_b_a[((long)l * 2 + dir) * 512 + h * 128 + d];
  __syncthreads();
  for (int i = tid; i < 8192; i += NTHREADS) ((unsigned*)sT)[i] = 0u;
  f32x16 Sacc;
#pragma unroll
  for (int r = 0; r < 16; ++r) Sacc[r] = 0.f;
  const int dblk = wid >> 1, eblk = wid & 1, iblk = (wid >> 1) & 1;
  u32x4 pq0, pq1, pk0, pk1, pv; u16 pg0, pg1;
  const int row0 = tid >> 4, chq = tid & 15;
  const int vi0 = tid >> 3, ve8 = (tid & 7) * 8;
  const int g0i = (tid * 2) >> 4, g0r = (tid * 2) & 15;
#define GLOADC(cc_) do { \
    const u16* f0_ = feat + gla_row(bi, dir, (cc_), row0) * NF + h * 128 + chq * 8; \
    const u16* f1_ = feat + gla_row(bi, dir, (cc_), 32 + row0) * NF + h * 128 + chq * 8; \
    pq0 = *(const u32x4*)(f0_ + F_GQ); pk0 = *(const u32x4*)(f0_ + F_GK); pq1 = *(const u32x4*)(f1_ + F_GQ); pk1 = *(const u32x4*)(f1_ + F_GK); \
    pv = *(const u32x4*)(feat + gla_row(bi, dir, (cc_), vi0) * NF + F_GV + h * 256 + sl * 64 + ve8); \
    const u16* g_ = feat + gla_row(bi, dir, (cc_), g0i) * NF + F_GA + dir * 16 + g0r; pg0 = g_[0]; pg1 = g_[1]; } while (0)
  GLOADC(0);
  int cur = 0;
  for (int cc = 0; cc < 132; ++cc) {
    {
      const int so0 = row0 * 256 + ((chq ^ (row0 & 7)) << 4), so1 = so0 + 32 * 256;
      *(u32x4*)(qs + so0) = pq0; *(u32x4*)(ks + so0) = pk0; *(u32x4*)(qs + so1) = pq1; *(u32x4*)(ks + so1) = pk1;
#pragma unroll
      for (int j = 0; j < 4; ++j) {
        *(u16*)(vT + (ve8 + 2 * j) * 144 + vi0 * 2) = (u16)(pv[j] & 0xffffu);
        *(u16*)(vT + (ve8 + 2 * j + 1) * 144 + vi0 * 2) = (u16)(pv[j] >> 16);
      }
      gas[tid * 2] = bf2f(pg0); gas[tid * 2 + 1] = bf2f(pg1);
    }
    __syncthreads();
    if (cc + 1 < 132) GLOADC(cc + 1);
    SBAR();
    float bcum[16];
    {
      float run = 0.f;
#pragma unroll
      for (int ii = 0; ii < 16; ++ii) {
        const float* gr_ = gas + (seg * 16 + ii) * 16;
        float z = ba;
#pragma unroll
        for (int r = 0; r < 16; ++r) z += gr_[r] * w2[r];
        const float ls = fminf(z, 0.f) - __logf(1.f + __expf(-fabsf(z)));
        run += ls * (1.f / 16.f);
        bcum[ii] = run;
      }
      segtot[seg * 128 + d] = run;
    }
    __syncthreads();
    {
      float pre = 0.f, tot = 0.f;
#pragma unroll
      for (int s_ = 0; s_ < 4; ++s_) { const float v = segtot[s_ * 128 + d]; tot += v; if (s_ < seg) pre += v; }
      const float etot = __expf(tot);
      if (seg == 0) ebl[d] = etot;
#pragma unroll
      for (int ii = 0; ii < 16; ++ii) {
        const int i = seg * 16 + ii;
        const float bb = bcum[ii] + pre;
        const int so = i * 256 + (((d >> 3) ^ (i & 7)) << 4) + (d & 7) * 2;
        const float q = bf2f(*(const u16*)(qs + so)), k = bf2f(*(const u16*)(ks + so));
        const float eb = __expf(bb), ieb = __frcp_rn(eb);
        *(u16*)(qs + so) = f2bf(q * eb);
        *(u16*)(ks + so) = f2bf(k * ieb);
        *(u16*)(kT + d * 144 + i * 2) = f2bf(k * (etot * ieb));
      }
    }
    __syncthreads();
    const char* sTc = sT + cur * 16384; char* sTn = sT + (cur ^ 1) * 16384;
    if (wid < 4) {
      f32x16 p0, p1, o;
#pragma unroll
      for (int r = 0; r < 16; ++r) { p0[r] = 0.f; p1[r] = 0.f; o[r] = 0.f; }
      const int irow = iblk * 32 + r32;
#pragma unroll
      for (int d0 = 0; d0 < 8; ++d0) {
        const int chn = d0 * 2 + hi;
        const bf16x8 b0 = *(const bf16x8*)(ks + r32 * 256 + ((chn ^ (r32 & 7)) << 4));
        const bf16x8 b1 = *(const bf16x8*)(ks + (32 + r32) * 256 + ((chn ^ (r32 & 7)) << 4));
        const bf16x8 qf = *(const bf16x8*)(qs + irow * 256 + ((chn ^ (irow & 7)) << 4));
        p0 = __builtin_amdgcn_mfma_f32_32x32x16_bf16(b0, qf, p0, 0, 0, 0);
        p1 = __builtin_amdgcn_mfma_f32_32x32x16_bf16(b1, qf, p1, 0, 0, 0);
      }
#pragma unroll
      for (int r = 0; r < 16; ++r) {
        const int j0 = crow(r, hi), j1 = 32 + j0;
        const bool k0 = dir ? (j0 < irow) : (j0 <= irow), k1 = dir ? (j1 < irow) : (j1 <= irow);
        p0[r] = k0 ? p0[r] : 0.f; p1[r] = k1 ? p1[r] : 0.f;
      }
      bf16x8 pa0, pa1, pa2, pa3;
      PK4(p0, 0, pa0); PK4(p0, 8, pa1); PK4(p1, 0, pa2); PK4(p1, 8, pa3);
      const char* vrow = vT + (eblk * 32 + r32) * 144 + hi * 16;
      o = __builtin_amdgcn_mfma_f32_32x32x16_bf16(pa0, *(const bf16x8*)(vrow), o, 0, 0, 0);
      o = __builtin_amdgcn_mfma_f32_32x32x16_bf16(pa1, *(const bf16x8*)(vrow + 32), o, 0, 0, 0);
      o = __builtin_amdgcn_mfma_f32_32x32x16_bf16(pa2, *(const bf16x8*)(vrow + 64), o, 0, 0, 0);
      o = __builtin_amdgcn_mfma_f32_32x32x16_bf16(pa3, *(const bf16x8*)(vrow + 96), o, 0, 0, 0);
      const int erow = eblk * 32 + r32;
#pragma unroll
      for (int d0 = 0; d0 < 8; ++d0) {
        const int chn = d0 * 2 + hi;
        const bf16x8 qf = *(const bf16x8*)(qs + irow * 256 + ((chn ^ (irow & 7)) << 4));
        const bf16x8 sf = *(const bf16x8*)(sTc + erow * 256 + ((chn ^ (erow & 7)) << 4));
        o = __builtin_amdgcn_mfma_f32_32x32x16_bf16(qf, sf, o, 0, 0, 0);
      }
#pragma unroll
      for (int r = 0; r < 16; ++r)
        og[gla_row(bi, dir, cc, iblk * 32 + crow(r, hi)) * 1024 + h * 256 + sl * 64 + eblk * 32 + r32] = f2bf(o[r]);
    }
    {
#pragma unroll
      for (int r = 0; r < 16; ++r) Sacc[r] *= ebl[dblk * 32 + crow(r, hi)];
      const char* krow = kT + (dblk * 32 + r32) * 144 + hi * 16;
      const char* vrow = vT + (eblk * 32 + r32) * 144 + hi * 16;
#pragma unroll
      for (int k16 = 0; k16 < 4; ++k16)
        Sacc = __builtin_amdgcn_mfma_f32_32x32x16_bf16(*(const bf16x8*)(krow + k16 * 32), *(const bf16x8*)(vrow + k16 * 32), Sacc, 0, 0, 0);
      const int erow = eblk * 32 + r32;
#pragma unroll
      for (int q4 = 0; q4 < 4; ++q4) {
        const int chn = dblk * 4 + q4;
        u32x2 w = {cvtpk(Sacc[q4 * 4 + 0], Sacc[q4 * 4 + 1]), cvtpk(Sacc[q4 * 4 + 2], Sacc[q4 * 4 + 3])};
        *(u32x2*)(sTn + erow * 256 + ((chn ^ (erow & 7)) << 4) + hi * 8) = w;
      }
    }
    cur ^= 1;
    __syncthreads();
  }
#undef GLOADC
}

DEVI void phase_mix(const Params& p, int ps, int l, char* lds) {
  __shared__ int s_q;
  const u16* feat = (const u16*)(p.ws + OFF_FEAT);
  const u16* qm = (const u16*)(p.ws + OFF_QM);
  const u16* kvb = (const u16*)(p.ws + OFF_KV);
  u16* od = (u16*)(p.ws + OFF_OD);
  u16* yc = (u16*)(p.ws + OFF_YC);
  const int x = blockIdx.x & 7, jb = blockIdx.x >> 3;
  if (jb < 8) gla_seq(p, l, x * 8 + jb, lds);
  int* ctr = (int*)(p.ws + OFF_CTR) + 128 + (ps * 2 + l) * 8 + x;
  const int nmla = NBP * 32, ndiff = NBP * 64, nctx = (l == 0) ? (NBP * 24 / 8) : 0;
  for (;;) {
    __syncthreads();
    if (otid() == 0) s_q = atomicAdd(ctr, 1);
    __syncthreads();
    const int q = s_q;
    if (q >= nmla) break;
    const int bi = q >> 5, h = x, q0 = bi * ROWS + (q & 31) * 256;
    const long k0 = (long)bi * ROWS;
    attn_body<192, false>(qm + (long)q0 * 1536 + h * 192, 1536, kvb + k0 * 2048 + h * 256, 2048, feat + k0 * NF + F_KR, NF,
                          kvb + k0 * 2048 + h * 256 + 128, 2048, yc + (long)q0 * 1024 + h * 128, 1024, ROWS, 0.07216878364870322f, lds);
  }
  int* ctr2 = ctr + 128;
  for (;;) {
    __syncthreads();
    if (otid() == 0) s_q = atomicAdd(ctr2, 1);
    __syncthreads();
    const int q = s_q;
    if (q >= ndiff + nctx) break;
    if (q < ndiff) {
      const int bi = q >> 6, hm = x + 8 * ((q >> 5) & 1), h = hm >> 1, mp = hm & 1, q0 = bi * ROWS + (q & 31) * 256;
      const long k0 = (long)bi * ROWS;
      attn_body<64, true>(feat + (long)q0 * NF + F_DQ + h * 128 + mp * 64, NF, feat + k0 * NF + F_DK + h * 128 + mp * 64, NF, feat, NF,
                          feat + k0 * NF + F_DV + h * 128, NF, od + (long)mp * RP * 1024 + (long)q0 * 1024 + h * 128, 1024, ROWS, 0.125f, lds);
    } else {
      const int u = (q - ndiff) * 8 + x, bi = u / 24, v = u % 24;
      const long c0 = (long)bi * ROWS + SEQ;
      if (v < 8) {
        const int h = v;
        attn_body<192, false>(qm + c0 * 1536 + h * 192, 1536, kvb + c0 * 2048 + h * 256, 2048, feat + c0 * NF + F_KR, NF,
                              kvb + c0 * 2048 + h * 256 + 128, 2048, yc + c0 * 1024 + h * 128, 1024, CTXL, 0.07216878364870322f, lds);
      } else {
        const int h = (v - 8) >> 1, mp = (v - 8) & 1;
        attn_body<64, true>(feat + c0 * NF + F_DQ + h * 128 + mp * 64, NF, feat + c0 * NF + F_DK + h * 128 + mp * 64, NF, feat, NF,
                            feat + c0 * NF + F_DV + h * 128, NF, od + (long)mp * RP * 1024 + c0 * 1024 + h * 128, 1024, CTXL, 0.125f, lds);
      }
    }
  }
}

DEVI void grid_bar(unsigned* ctr, unsigned& epoch) {
  asm volatile("s_waitcnt vmcnt(0)" ::: "memory");
  __syncthreads();
  if (threadIdx.x == 0) {
    __builtin_amdgcn_fence(__ATOMIC_RELEASE, "agent");
    asm volatile("s_waitcnt vmcnt(0)" ::: "memory");
    __hip_atomic_fetch_add(ctr, 1u, __ATOMIC_RELAXED, __HIP_MEMORY_SCOPE_AGENT);
    const unsigned target = (epoch + 1u) * gridDim.x;
    while (__hip_atomic_load(ctr, __ATOMIC_RELAXED, __HIP_MEMORY_SCOPE_AGENT) < target) __builtin_amdgcn_s_sleep(1);
    __builtin_amdgcn_fence(__ATOMIC_ACQUIRE, "agent");
    asm volatile("s_waitcnt vmcnt(0)" ::: "memory");
  }
  __syncthreads();
  ++epoch;
}

__global__ void __launch_bounds__(NTHREADS) fwd_megakernel(Params p) {
  extern __shared__ __attribute__((aligned(16))) char lds[];
  cg::grid_group grid = cg::this_grid();
  if (blockIdx.x == 0) ((int*)(p.ws + OFF_CTR))[threadIdx.x] = 0;
  unsigned* gbar = (unsigned*)(p.ws + OFF_CTR) + 96; unsigned epoch = 0;
  for (int l = 0; l < 2; ++l) {
    conv_weight(p.w_in + (long)l * 1024 * NIN_ORIG, NIN_ORIG, (u16*)(p.ws + OFF_WIN) + (long)l * NF * 1024, NF, 1024, 1, nullptr, lds);
    conv_weight(p.mla_w_uq + (long)l * 256 * 1536, 1536, (u16*)(p.ws + OFF_WUQ) + (long)l * 1536 * 256, 1536, 256, 0, p.mla_q_norm_g + l * 256, lds);
    conv_weight(p.mla_w_ukv + (long)l * 128 * 2048, 2048, (u16*)(p.ws + OFF_WUKV) + (long)l * 2048 * 128, 2048, 128, 0, p.mla_kv_norm_g + l * 128, lds);
    for (int i = 0; i < 3; ++i)
      conv_weight(p.w_branch + ((long)l * 3 + i) * 1024 * 1024, 1024, (u16*)(p.ws + OFF_WBR) + ((long)l * 3 + i) * 1024 * 1024, 1024, 1024, 0, nullptr, lds);
    conv_weight(p.w_out + (long)l * 1024 * 1024, 1024, (u16*)(p.ws + OFF_WOUT) + (long)l * 1024 * 1024, 1024, 1024, 0, nullptr, lds);
    conv_weight(p.ffn_w_in + (long)l * 1024 * 5632, 5632, (u16*)(p.ws + OFF_WF1) + (long)l * 5632 * 1024, 5632, 1024, 2, nullptr, lds);
    conv_weight(p.ffn_w_out + (long)l * FH * 1024, 1024, (u16*)(p.ws + OFF_WF2) + (long)l * 1024 * FH, 1024, FH, 0, nullptr, lds);
  }
  phase_modv(p, lds);
  phase_rope(p);
  grid.sync();
  phase_mod1_l0(p, 0);
  grid_bar(gbar, epoch);
  for (int ps = 0; ps < NPASS; ++ps) {
    for (int l = 0; l < 2; ++l) {
      phase_gemm_in(p, l, lds);              grid_bar(gbar, epoch);
      phase_gemm_up(p, l, lds);              grid_bar(gbar, epoch);
      phase_mix(p, ps, l, lds);              grid_bar(gbar, epoch);
      phase_prep(p, l);                      grid_bar(gbar, epoch);
      phase_gemm_br(p, l, lds);              grid_bar(gbar, epoch);
      phase_gemm_res(p, ps, l, 2, lds);      grid_bar(gbar, epoch);
      phase_rows_a(p, ps, l);                grid_bar(gbar, epoch);
      phase_gemm_f1(p, l, lds);              grid_bar(gbar, epoch);
      phase_gemm_res(p, ps, l, 5, lds);      grid_bar(gbar, epoch);
      phase_rows_b(p, ps, l);                if (!(ps == NPASS - 1 && l == 1)) grid_bar(gbar, epoch);
    }
  }
}

extern "C" void kernel_launch(void* const* d_in, const int* in_sizes, int n_in, void* d_out, int out_size, void* d_ws, size_t ws_size, hipStream_t stream) {
  static int grid_blocks = 0;
  if (grid_blocks == 0) {
    if (n_in != 24 || ws_size < WS_END) { fprintf(stderr, "kernel_launch: n_in %d ws %zu need %zu\n", n_in, ws_size, (size_t)WS_END); grid_blocks = -1; return; }
    int dev = 0, cus = 0, per_cu = 0;
    hipGetDevice(&dev);
    hipDeviceGetAttribute(&cus, hipDeviceAttributeMultiprocessorCount, dev);
    if (hipFuncSetAttribute((const void*)fwd_megakernel, hipFuncAttributeMaxDynamicSharedMemorySize, LDS_BYTES) != hipSuccess) { fprintf(stderr, "kernel_launch: LDS attr failed\n"); grid_blocks = -1; return; }
    hipOccupancyMaxActiveBlocksPerMultiprocessor(&per_cu, (const void*)fwd_megakernel, NTHREADS, LDS_BYTES);
    if (per_cu < 1) { fprintf(stderr, "kernel_launch: occupancy %d\n", per_cu); per_cu = 1; }
    if (per_cu > 1) per_cu = 1;
    grid_blocks = cus * per_cu;
  }
  if (grid_blocks < 0) return;
  Params p{};
  const float** pp = (const float**)&p;
  for (int i = 0; i < 24; ++i) pp[i] = (const float*)d_in[i];
  p.out = (float*)d_out; p.ws = (char*)d_ws;
  void* args[] = {&p};
  hipError_t e = hipLaunchCooperativeKernel((const void*)fwd_megakernel, dim3(grid_blocks), dim3(NTHREADS), args, LDS_BYTES, stream);
  if (e != hipSuccess) fprintf(stderr, "cooperative launch failed: %s (grid %d)\n", hipGetErrorString(e), grid_blocks);
}
```

```cpp
#include <hip/hip_runtime.h>
#include <hip/hip_bf16.h>
#include <hip/hip_cooperative_groups.h>
#include <cstdio>
#include <cstdint>
namespace cg = cooperative_groups;

#define DEVI __device__ __forceinline__
typedef unsigned short u16;
typedef __attribute__((ext_vector_type(8))) short bf16x8;
typedef __attribute__((ext_vector_type(4))) short s16x4;
typedef __attribute__((ext_vector_type(16))) float f32x16;
typedef __attribute__((ext_vector_type(4))) float f32x4;
typedef __attribute__((ext_vector_type(4))) unsigned u32x4;
typedef __attribute__((ext_vector_type(2))) unsigned u32x2;

constexpr int DM = 1024, NBATCH = 8, SEQ = 8192, CTXL = 256, ROWS = SEQ + CTXL;
constexpr int NF = 9728;
constexpr int F_GQ = 0, F_GK = 512, F_GV = 1024, F_GR = 2048, F_DQ = 3072, F_DK = 4096, F_DV = 5120, F_MQ = 6144, F_MKV = 6400,
              F_GATE = 6528, F_KR = 9600, F_GA = 9664;
constexpr int FH = 2816;
constexpr int NIN_ORIG = 9696;
constexpr float ALPHA = 1.4142135623730951f;
constexpr float EPS = 1e-6f;
constexpr int NTHREADS = 512;
constexpr int NBP = 2, RP = NBP * ROWS, NPASS = NBATCH / NBP;

constexpr size_t al256(size_t x) { return (x + 255) / 256 * 256; }
constexpr size_t OFF_WIN  = 0;
constexpr size_t OFF_WUQ  = OFF_WIN  + al256((size_t)2 * NF * 1024 * 2);
constexpr size_t OFF_WUKV = OFF_WUQ  + al256((size_t)2 * 1536 * 256 * 2);
constexpr size_t OFF_WBR  = OFF_WUKV + al256((size_t)2 * 2048 * 128 * 2);
constexpr size_t OFF_WOUT = OFF_WBR  + al256((size_t)2 * 3 * 1024 * 1024 * 2);
constexpr size_t OFF_WF1  = OFF_WOUT + al256((size_t)2 * 1024 * 1024 * 2);
constexpr size_t OFF_WF2  = OFF_WF1  + al256((size_t)2 * 5632 * 1024 * 2);
constexpr size_t OFF_MODV = OFF_WF2  + al256((size_t)2 * 1024 * 2816 * 2);
constexpr size_t OFF_ROPE = OFF_MODV + al256((size_t)2 * 9 * 6144 * 4);
constexpr size_t OFF_CTR  = OFF_ROPE + al256((size_t)SEQ * 64 * 4);
constexpr size_t OFF_XC   = OFF_CTR  + 2048;
constexpr size_t OFF_H    = OFF_XC   + al256((size_t)NBP * CTXL * 1024 * 4);
constexpr size_t OFF_FEAT = OFF_H    + al256((size_t)RP * 1024 * 2);
constexpr size_t OFF_QM   = OFF_FEAT + al256((size_t)RP * NF * 2);
constexpr size_t OFF_KV   = OFF_QM   + al256((size_t)RP * 1536 * 2);
constexpr size_t OFF_OG   = OFF_KV   + al256((size_t)RP * 2048 * 2);
constexpr size_t OFF_OD   = OFF_OG   + al256((size_t)2 * RP * 1024 * 2);
constexpr size_t OFF_YC   = OFF_OD   + al256((size_t)2 * RP * 1024 * 2);
constexpr size_t WS_END   = OFF_YC   + al256((size_t)RP * 1024 * 2);
constexpr size_t OFF_YA   = OFF_OG;
constexpr size_t OFF_YB   = OFF_OD;
constexpr size_t OFF_Y    = OFF_H;
constexpr size_t OFF_HID  = OFF_FEAT;

constexpr int LDS_BYTES = 140 * 1024;

struct Params {
  const float *x, *c, *ctx, *c_ctx, *w_mod, *b_mod, *w_in, *gla_w_a2, *gla_b_a, *gla_norm_g, *diff_lam, *diff_norm_g,
      *mla_q_norm_g, *mla_kv_norm_g, *mla_w_uq, *mla_w_ukv, *w_branch, *w_out, *ln1_g, *ln1_b, *ffn_w_in, *ffn_w_out, *ln2_g, *ln2_b;
  float* out;
  char* ws;
};

typedef float f32x2_t __attribute__((ext_vector_type(2)));
typedef __bf16 bf16x2_t __attribute__((ext_vector_type(2)));
DEVI unsigned cvtpk(float lo, float hi) { f32x2_t v = {lo, hi}; bf16x2_t b = __builtin_convertvector(v, bf16x2_t); return __builtin_bit_cast(unsigned, b); }
DEVI u16 f2bf(float f) { return (u16)(cvtpk(f, 0.f) & 0xffffu); }
DEVI float bf2f(u16 h) { return __uint_as_float(((unsigned)h) << 16); }
DEVI float bflo(unsigned w) { return __uint_as_float(w << 16); }
DEVI float bfhi(unsigned w) { return __uint_as_float(w & 0xffff0000u); }
DEVI void st4bf(u16* p, float a, float b, float c, float d) { u32x2 w = {cvtpk(a, b), cvtpk(c, d)}; *(u32x2*)p = w; }
DEVI float wave_sum(float v) {
#pragma unroll
  for (int m = 32; m >= 1; m >>= 1) v += __shfl_xor(v, m);
  return v;
}
DEVI float siluf(float x) { return x / (1.f + expf(-x)); }
DEVI float sigmf(float x) { return 1.f / (1.f + expf(-x)); }
DEVI int crow(int r, int hi) { return (r & 3) + 8 * (r >> 2) + 4 * hi; }
#define SBAR() __builtin_amdgcn_sched_barrier(0)

DEVI int vblock() { return (int)(blockIdx.x & 7) * (int)(gridDim.x >> 3) + (int)(blockIdx.x >> 3); }
DEVI void tile_map(int t, int NTM, int NTN, int& tm, int& tn) {
  const int per = NTM * 4, g = t / per, r = t - g * per;
  const int w = (NTN - g * 4) < 4 ? (NTN - g * 4) : 4;
  tm = r / w; tn = g * 4 + (r - tm * w);
}
DEVI int otid() { int t = threadIdx.x; asm volatile("" : "+v"(t)); return t; }

template <int MI, int NC>
DEVI void mfma_tile(f32x16 (&acc)[2 * NC][MI], const char* Ab, const char* Bb, int rowa0, int rowb0, int sa, int sb, int hi) {
  if constexpr (MI * NC >= 4) {
#pragma unroll
    for (int k16 = 0; k16 < 4; ++k16) {
      const int chn = k16 * 2 + hi;
      bf16x8 ga[2 * NC], gb[MI];
#pragma unroll
      for (int ni = 0; ni < 2 * NC; ++ni) ga[ni] = *(const bf16x8*)(Bb + (rowa0 + 32 * ni) * 128 + ((chn ^ sa) << 4));
#pragma unroll
      for (int mi = 0; mi < MI; ++mi) gb[mi] = *(const bf16x8*)(Ab + (rowb0 + 32 * mi) * 128 + ((chn ^ sb) << 4));
#pragma unroll
      for (int ni = 0; ni < 2 * NC; ++ni)
#pragma unroll
        for (int mi = 0; mi < MI; ++mi)
          acc[ni][mi] = __builtin_amdgcn_mfma_f32_32x32x16_bf16(ga[ni], gb[mi], acc[ni][mi], 0, 0, 0);
    }
    return;
  }
  bf16x8 fa[2][2 * NC], fb[2][MI];
#pragma unroll
  for (int ni = 0; ni < 2 * NC; ++ni) fa[0][ni] = *(const bf16x8*)(Bb + (rowa0 + 32 * ni) * 128 + ((hi ^ sa) << 4));
#pragma unroll
  for (int mi = 0; mi < MI; ++mi) fb[0][mi] = *(const bf16x8*)(Ab + (rowb0 + 32 * mi) * 128 + ((hi ^ sb) << 4));
#pragma unroll
  for (int k16 = 0; k16 < 4; ++k16) {
    if (k16 < 3) {
      const int chn = (k16 + 1) * 2 + hi;
#pragma unroll
      for (int ni = 0; ni < 2 * NC; ++ni) fa[(k16 + 1) & 1][ni] = *(const bf16x8*)(Bb + (rowa0 + 32 * ni) * 128 + ((chn ^ sa) << 4));
#pragma unroll
      for (int mi = 0; mi < MI; ++mi) fb[(k16 + 1) & 1][mi] = *(const bf16x8*)(Ab + (rowb0 + 32 * mi) * 128 + ((chn ^ sb) << 4));
    }
    SBAR();
#pragma unroll
    for (int ni = 0; ni < 2 * NC; ++ni)
#pragma unroll
      for (int mi = 0; mi < MI; ++mi)
        acc[ni][mi] = __builtin_amdgcn_mfma_f32_32x32x16_bf16(fa[k16 & 1][ni], fb[k16 & 1][mi], acc[ni][mi], 0, 0, 0);
    SBAR();
  }
}

template <int MI, int NC>
DEVI void gemm_kloop(f32x16 (&acc)[2 * NC][MI], const u16* __restrict__ A, long lda, const u16* __restrict__ Bt, long ldb, int K, char* lds) {
  const int tid = otid(), wid = tid >> 6, lane = tid & 63, r32 = lane & 31, hi = lane >> 5;
  const int wm = wid & 3, wn = wid >> 2;
  constexpr int ABUF = 32768, BBUF = 16384 * NC;
  char* As = lds; char* Bs = lds + 65536;
  const int ch = tid & 7, rw = tid >> 3;
  const int swz = ((ch ^ ((rw >> 1) & 7)) << 4);
  u32x4 ra[2 * MI], rb[2 * NC];
  const u16* Ap = A + (long)rw * lda + ch * 8;
  const u16* Bp = Bt + (long)rw * ldb + ch * 8;
#define GLOAD(k0) do { _Pragma("unroll") for (int i_ = 0; i_ < 2 * MI; ++i_) ra[i_] = *(const u32x4*)(Ap + (long)(64 * i_) * lda + (k0)); \
    _Pragma("unroll") for (int i_ = 0; i_ < 2 * NC; ++i_) rb[i_] = *(const u32x4*)(Bp + (long)(64 * i_) * ldb + (k0)); } while (0)
#define GWRITE(buf) do { char* a_ = As + (buf) * ABUF + rw * 128 + swz; char* b_ = Bs + (buf) * BBUF + rw * 128 + swz; \
    _Pragma("unroll") for (int i_ = 0; i_ < 2 * MI; ++i_) *(u32x4*)(a_ + i_ * 64 * 128) = ra[i_]; \
    _Pragma("unroll") for (int i_ = 0; i_ < 2 * NC; ++i_) *(u32x4*)(b_ + i_ * 64 * 128) = rb[i_]; } while (0)
#pragma unroll
  for (int i = 0; i < 2 * NC; ++i)
#pragma unroll
    for (int j = 0; j < MI; ++j)
#pragma unroll
      for (int r = 0; r < 16; ++r) acc[i][j][r] = 0.f;
  const int KT = K >> 6;
  const int grp = __builtin_amdgcn_readfirstlane(wid) >> 2;
  const int rowa0 = wn * (64 * NC) + r32, rowb0 = wm * (32 * MI) + r32;
  const int sa = (rowa0 >> 1) & 7, sb = (rowb0 >> 1) & 7;
#define MFMA_ALL(kt_) mfma_tile<MI, NC>(acc, As + ((kt_) & 1) * ABUF, Bs + ((kt_) & 1) * BBUF, rowa0, rowb0, sa, sb, hi)
#define KBAR() do { asm volatile("s_waitcnt lgkmcnt(0)" ::: "memory"); __builtin_amdgcn_s_barrier(); asm volatile("" ::: "memory"); } while (0)
  GLOAD(0); GWRITE(0); SBAR();
  if (KT > 1) GLOAD(64);
  KBAR();
  if (grp == 0) {
    for (int kt = 0; kt < KT; ++kt) {
      MFMA_ALL(kt);
      KBAR();
      if (kt + 1 < KT) { GWRITE((kt + 1) & 1); if (kt + 2 < KT) GLOAD((kt + 2) * 64); }
      KBAR();
    }
  } else {
    for (int kt = 0; kt < KT; ++kt) {
      if (kt + 1 < KT) { GWRITE((kt + 1) & 1); if (kt + 2 < KT) GLOAD((kt + 2) * 64); }
      KBAR();
      MFMA_ALL(kt);
      KBAR();
    }
  }
#undef KBAR
#undef MFMA_ALL
#undef GLOAD
#undef GWRITE
}

DEVI int map_col(int mode, int n) {
  if (mode == 0) return n;
  if (mode == 1) {
    if (n < 3072) return n;
    if (n < 6528) return n + 32;
    if (n < 9600) return n + 96;
    if (n < 9664) return 6560 + (n - 9600);
    if (n < 9696) return 3072 + (n - 9664);
    return -1;
  }
  const int grp = n >> 6, w = n & 63;
  return (w < 32) ? (grp * 32 + w) : (FH + grp * 32 + (w - 32));
}
DEVI void conv_weight(const float* __restrict__ src, int ldsrc, u16* __restrict__ dst, int Ndst, int K, int mode, const float* __restrict__ kscale, char* lds) {
  float* t = (float*)lds;
  const int tid = otid();
  const int ntn = Ndst >> 6, ntk = K >> 6;
  for (int tile = blockIdx.x; tile < ntn * ntk; tile += gridDim.x) {
    const int n0 = (tile / ntk) << 6, k0 = (tile % ntk) << 6;
    __syncthreads();
#pragma unroll
    for (int it = 0; it < 2; ++it) {
      const int idx = tid + it * NTHREADS, kk = idx >> 4, n4 = (idx & 15) * 4;
      const int sc = map_col(mode, n0 + n4);
      f32x4 v = {0.f, 0.f, 0.f, 0.f};
      if (sc >= 0) v = *(const f32x4*)(src + (long)(k0 + kk) * ldsrc + sc);
      if (kscale) { const float ks = kscale[k0 + kk]; v[0] *= ks; v[1] *= ks; v[2] *= ks; v[3] *= ks; }
      t[(n4 + 0) * 68 + kk] = v[0]; t[(n4 + 1) * 68 + kk] = v[1]; t[(n4 + 2) * 68 + kk] = v[2]; t[(n4 + 3) * 68 + kk] = v[3];
    }
    __syncthreads();
    {
      const int nn = tid >> 3, k8 = (tid & 7) * 8;
      const f32x4 a = *(const f32x4*)(t + nn * 68 + k8), c = *(const f32x4*)(t + nn * 68 + k8 + 4);
      u32x4 w = {cvtpk(a[0], a[1]), cvtpk(a[2], a[3]), cvtpk(c[0], c[1]), cvtpk(c[2], c[3])};
      *(u32x4*)(dst + (long)(n0 + nn) * K + k0 + k8) = w;
    }
  }
  __syncthreads();
}

DEVI void phase_modv(const Params& p, char* lds) {
  float* ca = (float*)lds;
  float* red = ca + 9 * 1024;
  float* modv = (float*)(p.ws + OFF_MODV);
  const int tid = otid();
  __syncthreads();
  for (int i = tid; i < 9 * 1024; i += NTHREADS) {
    const float v = (i < 8192) ? p.c[i] : p.c_ctx[i - 8192];
    ca[i] = siluf(v);
  }
  __syncthreads();
  const int col = tid & 63, ks = tid >> 6;
  for (int tile = blockIdx.x; tile < 2 * 96; tile += gridDim.x) {
    const int l = tile / 96, n0 = (tile % 96) * 64;
    const float* W = p.w_mod + (long)l * 1024 * 6144 + n0 + col;
    float a[9];
#pragma unroll
    for (int j = 0; j < 9; ++j) a[j] = 0.f;
    for (int k = ks * 128; k < ks * 128 + 128; ++k) {
      const float w = W[(long)k * 6144];
#pragma unroll
      for (int j = 0; j < 9; ++j) a[j] += ca[j * 1024 + k] * w;
    }
#pragma unroll
    for (int j = 0; j < 9; ++j) red[(ks * 64 + col) * 9 + j] = a[j];
    __syncthreads();
    for (int i = tid; i < 64 * 9; i += NTHREADS) {
      const int cc = i / 9, j = i % 9;
      float s = 0.f;
      for (int q = 0; q < 8; ++q) s += red[(q * 64 + cc) * 9 + j];
      modv[((long)l * 9 + j) * 6144 + n0 + cc] = s + p.b_mod[l * 6144 + n0 + cc];
    }
    __syncthreads();
  }
}

DEVI void phase_rope(const Params& p) {
  float* rope = (float*)(p.ws + OFF_ROPE);
  for (int i = blockIdx.x * NTHREADS + otid(); i < SEQ * 32; i += gridDim.x * NTHREADS) {
    const int t = i >> 5, f = i & 31;
    const float inv = powf(10000.f, -(float)(f & 15) / 16.f);
    const float pos = (f < 16) ? (float)(t >> 6) : (float)(t & 63);
    const float ang = pos * inv;
    rope[t * 64 + f] = cosf(ang);
    rope[t * 64 + 32 + f] = sinf(ang);
  }
}

DEVI void ln_stats(const float (&v)[16], float& mu, float& rstd) {
  float s = 0.f;
#pragma unroll
  for (int i = 0; i < 16; ++i) s += v[i];
  mu = wave_sum(s) * (1.f / 1024.f);
  float q = 0.f;
#pragma unroll
  for (int i = 0; i < 16; ++i) { const float d = v[i] - mu; q += d * d; }
  rstd = rsqrtf(wave_sum(q) * (1.f / 1024.f) + EPS);
}
DEVI void rowload(const float* __restrict__ src, float (&v)[16]) {
  const int lane = otid() & 63;
#pragma unroll
  for (int i = 0; i < 4; ++i) {
    const f32x4 t = *(const f32x4*)(src + i * 256 + lane * 4);
    v[i * 4 + 0] = t[0]; v[i * 4 + 1] = t[1]; v[i * 4 + 2] = t[2]; v[i * 4 + 3] = t[3];
  }
}
DEVI void rowproc(float (&v)[16], float* __restrict__ dst, const float* __restrict__ ag, const float* __restrict__ ab,
                  u16* __restrict__ hout, const float* __restrict__ sh, const float* __restrict__ sc) {
  const int lane = otid() & 63;
  float mu, rstd;
  if (ag) {
    ln_stats(v, mu, rstd);
#pragma unroll
    for (int i = 0; i < 4; ++i) {
      const f32x4 g = *(const f32x4*)(ag + i * 256 + lane * 4);
      const f32x4 b = *(const f32x4*)(ab + i * 256 + lane * 4);
      f32x4 o;
#pragma unroll
      for (int j = 0; j < 4; ++j) { v[i * 4 + j] = (v[i * 4 + j] - mu) * rstd * g[j] + b[j]; o[j] = v[i * 4 + j]; }
      *(f32x4*)(dst + i * 256 + lane * 4) = o;
    }
  }
  if (hout) {
    ln_stats(v, mu, rstd);
#pragma unroll
    for (int i = 0; i < 4; ++i) {
      const f32x4 s1 = *(const f32x4*)(sc + i * 256 + lane * 4);
      const f32x4 s0 = *(const f32x4*)(sh + i * 256 + lane * 4);
      float h[4];
#pragma unroll
      for (int j = 0; j < 4; ++j) h[j] = (v[i * 4 + j] - mu) * rstd * (1.f + s1[j]) + s0[j];
      st4bf(hout + i * 256 + lane * 4, h[0], h[1], h[2], h[3]);
    }
  }
}
DEVI int rr_of(int r) { return r >= ROWS ? r - ROWS : r; }
DEVI int bi_of(int r) { return r >= ROWS ? 1 : 0; }
DEVI const float* modvec(const Params& p, int l, int ps, int r, int which) {
  const float* modv = (const float*)(p.ws + OFF_MODV);
  const int j = (rr_of(r) < SEQ) ? (ps * NBP + bi_of(r)) : 8;
  return modv + ((long)l * 9 + j) * 6144 + which * 1024;
}
DEVI const float* inrow(const Params& p, int ps, int r) {
  const int b = ps * NBP + bi_of(r), rr = rr_of(r);
  return (rr < SEQ) ? (p.x + ((long)b * SEQ + rr) * 1024) : (p.ctx + ((long)b * CTXL + (rr - SEQ)) * 1024);
}
DEVI float* xrow(const Params& p, int ps, int r) {
  const int b = ps * NBP + bi_of(r), rr = rr_of(r);
  return (rr < SEQ) ? (p.out + ((long)b * SEQ + rr) * 1024) : ((float*)(p.ws + OFF_XC) + (long)(bi_of(r) * CTXL + rr - SEQ) * 1024);
}
DEVI int row_next(int r, int nw, bool skipctx) { while (r < RP && skipctx && rr_of(r) >= SEQ) r += nw; return r; }
DEVI void row_loop(const Params& p, int ps, int l, int kind) {
  const int gw = blockIdx.x * 8 + (otid() >> 6), nw = gridDim.x * 8;
  const bool skipctx = (kind == 1 && l == 1) || kind == 3;
  u16* Hb = (u16*)(p.ws + OFF_H);
  float v[16], vn[16];
  int r = row_next(gw, nw, skipctx);
  if (r < RP) rowload(kind == 0 ? inrow(p, ps, r) : xrow(p, ps, r), v);
  while (r < RP) {
    const int rn = row_next(r + nw, nw, skipctx);
    if (rn < RP) rowload(kind == 0 ? inrow(p, ps, rn) : xrow(p, ps, rn), vn);
    float* xr = xrow(p, ps, r);
    u16* hrow = Hb + (long)r * 1024;
    if (kind == 0)      rowproc(v, nullptr, nullptr, nullptr, hrow, modvec(p, 0, ps, r, 0), modvec(p, 0, ps, r, 1));
    else if (kind == 1) rowproc(v, xr, p.ln1_g + l * 1024, p.ln1_b + l * 1024, hrow, modvec(p, l, ps, r, 3), modvec(p, l, ps, r, 4));
    else if (kind == 2) rowproc(v, xr, p.ln2_g, p.ln2_b, hrow, modvec(p, 1, ps, r, 0), modvec(p, 1, ps, r, 1));
    else                rowproc(v, xr, p.ln2_g + 1024, p.ln2_b + 1024, nullptr, nullptr, nullptr);
#pragma unroll
    for (int i = 0; i < 16; ++i) v[i] = vn[i];
    r = rn;
  }
}
DEVI void phase_mod1_l0(const Params& p, int ps) { row_loop(p, ps, 0, 0); }
DEVI void phase_rows_a(const Params& p, int ps, int l) { row_loop(p, ps, l, 1); }
DEVI void phase_rows_b(const Params& p, int ps, int l) {
  if (l == 0) row_loop(p, ps, 0, 2);
  else { row_loop(p, ps, 1, 3); if (ps + 1 < NPASS) row_loop(p, ps + 1, 0, 0); }
}
DEVI int tile_m0(int tm, int l, int TR) { const int tpb = (l == 0 ? ROWS : SEQ) / TR; return (tm / tpb) * ROWS + (tm % tpb) * TR; }
DEVI int tile_ntm(int l, int TR) { return NBP * ((l == 0 ? ROWS : SEQ) / TR); }

template <int NCOLS> DEVI void wave_tile_store(const char* wl, u16* gbase, long ld, int lane) {
  constexpr int RS = NCOLS * 2 + 16, CPR = NCOLS / 8, RPI = 64 / CPR;
  const int rsub = lane / CPR, chk = lane % CPR;
  SBAR();
#pragma unroll 4
  for (int it = 0; it < 64 / RPI; ++it) {
    const int row = it * RPI + rsub;
    const u32x4 v = *(const u32x4*)(wl + row * RS + chk * 16);
    *(u32x4*)(gbase + (long)row * ld + chk * 8) = v;
  }
}
DEVI void lds_put4(char* wl, int RS, int row, int col, float a, float b, float c, float d) { u32x2 w = {cvtpk(a, b), cvtpk(c, d)}; *(u32x2*)(wl + row * RS + col * 2) = w; }

DEVI void phase_gemm_in(const Params& p, int l, char* lds) {
  const u16* H = (const u16*)(p.ws + OFF_H);
  const u16* W = (const u16*)(p.ws + OFF_WIN) + (long)l * NF * 1024;
  u16* feat = (u16*)(p.ws + OFF_FEAT);
  const float* rope = (const float*)(p.ws + OFF_ROPE);
  const int lane = otid() & 63, wid = otid() >> 6, r32 = lane & 31, hi = lane >> 5, wm = wid & 3, wn = wid >> 2;
  constexpr int NTN = NF / 256, NTM = RP / 256;
  for (int tile = vblock(); tile < NTN * NTM; tile += gridDim.x) {
    int tm, tn; tile_map(tile, NTM, NTN, tm, tn);
    const int m0 = tm * 256, n0 = tn * 256;
    f32x16 acc[4][2];
    __syncthreads();
    gemm_kloop<2, 2>(acc, H + (long)m0 * 1024, 1024, W + (long)n0 * 1024, 1024, 1024, lds);
    SBAR();
    char* wl = lds + wid * (64 * 272);
#pragma unroll
    for (int cg2 = 0; cg2 < 2; ++cg2) {
      SBAR();
      const int cb = n0 + wn * 128 + cg2 * 64;
      int mode = 0;
      if (cb < F_GK) mode = 1;
      else if ((cb >= F_DQ && cb < F_DV) || cb == F_KR) mode = 2;
      else if (cb >= F_GATE && cb < F_KR) mode = 3;
#pragma unroll
      for (int mi = 0; mi < 2; ++mi) {
        const int m = m0 + wm * 64 + mi * 32 + r32;
#pragma unroll
        for (int q = 0; q < 4; ++q) {
          const int ci = q * 8 + hi * 4;
          float x1[4], x2[4];
#pragma unroll
          for (int j = 0; j < 4; ++j) { x1[j] = acc[2 * cg2][mi][q * 4 + j]; x2[j] = acc[2 * cg2 + 1][mi][q * 4 + j]; }
          if (mode == 1) {
#pragma unroll
            for (int j = 0; j < 4; ++j) { x1[j] *= 0.08838834764831845f; x2[j] *= 0.08838834764831845f; }
          } else if (mode == 2) {
            if (rr_of(m) < SEQ) {
              const f32x4 cs = *(const f32x4*)(rope + (long)rr_of(m) * 64 + ci);
              const f32x4 sn = *(const f32x4*)(rope + (long)rr_of(m) * 64 + 32 + ci);
#pragma unroll
              for (int j = 0; j < 4; ++j) { const float a = x1[j], bb = x2[j]; x1[j] = a * cs[j] - bb * sn[j]; x2[j] = a * sn[j] + bb * cs[j]; }
            }
          } else if (mode == 3) {
#pragma unroll
            for (int j = 0; j < 4; ++j) { x1[j] = sigmf(x1[j]); x2[j] = sigmf(x2[j]); }
          }
          lds_put4(wl, 272, mi * 32 + r32, cg2 * 64 + ci, x1[0], x1[1], x1[2], x1[3]);
          lds_put4(wl, 272, mi * 32 + r32, cg2 * 64 + 32 + ci, x2[0], x2[1], x2[2], x2[3]);
        }
      }
    }
    wave_tile_store<128>(wl, feat + (long)(m0 + wm * 64) * NF + n0 + wn * 128, NF, lane);
  }
}

DEVI void phase_gemm_up(const Params& p, int l, char* lds) {
  const u16* feat = (const u16*)(p.ws + OFF_FEAT);
  const float* rope = (const float*)(p.ws + OFF_ROPE);
  float* rs = (float*)(lds + 98304);
  const int tid = otid(), lane = tid & 63, wid = tid >> 6, r32 = lane & 31, hi = lane >> 5, wm = wid & 3, wn = wid >> 2;
  constexpr int NTM = RP / 256, NQ = 12, NK = 16;
  for (int tile = vblock(); tile < NTM * (NQ + NK); tile += gridDim.x) {
    int tm, tn; tile_map(tile, NTM, NQ + NK, tm, tn);
    const bool isq = tn < NQ;
    const int m0 = tm * 256, n0 = (isq ? tn : tn - NQ) * 128;
    const int K = isq ? 256 : 128;
    const u16* A = feat + (long)m0 * NF + (isq ? F_MQ : F_MKV);
    const u16* W = isq ? ((const u16*)(p.ws + OFF_WUQ) + (long)l * 1536 * 256 + (long)n0 * 256)
                       : ((const u16*)(p.ws + OFF_WUKV) + (long)l * 2048 * 128 + (long)n0 * 128);
    __syncthreads();
    {
      const int row = tid >> 1, half = tid & 1, n8 = K / 16;
      const u16* ap = A + (long)row * NF + half * (K / 2);
      float ss = 0.f;
      for (int i = 0; i < n8; ++i) {
        const u32x4 w = *(const u32x4*)(ap + i * 8);
#pragma unroll
        for (int j = 0; j < 4; ++j) { const float a = bflo(w[j]), b = bfhi(w[j]); ss += a * a + b * b; }
      }
      ss += __shfl_xor(ss, 1);
      if (half == 0) rs[row] = rsqrtf(ss / (float)K + EPS);
    }
    f32x16 acc[2][2];
    gemm_kloop<2, 1>(acc, A, NF, W, K, K, lds);
    const int cb = n0 + wn * 64;
    const bool dorope = isq && ((cb % 192) == 128);
    u16* outp = isq ? (u16*)(p.ws + OFF_QM) : (u16*)(p.ws + OFF_KV);
    const int ldo = isq ? 1536 : 2048;
    char* wl = lds + wid * (64 * 144);
#pragma unroll
    for (int mi = 0; mi < 2; ++mi) {
      const int ml = wm * 64 + mi * 32 + r32, m = m0 + ml;
      const float sc = rs[ml];
#pragma unroll
      for (int q = 0; q < 4; ++q) {
        const int ci = q * 8 + hi * 4;
        float x1[4], x2[4];
#pragma unroll
        for (int j = 0; j < 4; ++j) { x1[j] = acc[0][mi][q * 4 + j] * sc; x2[j] = acc[1][mi][q * 4 + j] * sc; }
        if (dorope && rr_of(m) < SEQ) {
          const f32x4 cs = *(const f32x4*)(rope + (long)rr_of(m) * 64 + ci);
          const f32x4 sn = *(const f32x4*)(rope + (long)rr_of(m) * 64 + 32 + ci);
#pragma unroll
          for (int j = 0; j < 4; ++j) { const float a = x1[j], bb = x2[j]; x1[j] = a * cs[j] - bb * sn[j]; x2[j] = a * sn[j] + bb * cs[j]; }
        }
        lds_put4(wl, 144, mi * 32 + r32, ci, x1[0], x1[1], x1[2], x1[3]);
        lds_put4(wl, 144, mi * 32 + r32, 32 + ci, x2[0], x2[1], x2[2], x2[3]);
      }
    }
    wave_tile_store<64>(wl, outp + (long)(m0 + wm * 64) * ldo + cb, ldo, lane);
  }
}

DEVI void phase_gemm_br(const Params& p, int l, char* lds) {
  const u16* feat = (const u16*)(p.ws + OFF_FEAT);
  u16* Y = (u16*)(p.ws + OFF_Y);
  const int lane = otid() & 63, wid = otid() >> 6, r32 = lane & 31, hi = lane >> 5, wm = wid & 3, wn = wid >> 2;
  const int NTM = tile_ntm(l, 128);
  for (int tile = vblock(); tile < NTM * 8; tile += gridDim.x) {
    int tm, tn; tile_map(tile, NTM, 8, tm, tn);
    const int m0 = tile_m0(tm, l, 128), n0 = tn * 128;
    const int m = m0 + wm * 32 + r32;
    f32x16 tot[2];
#pragma unroll
    for (int i = 0; i < 3; ++i) {
      const u16* A = (const u16*)(p.ws + (i == 0 ? OFF_YA : (i == 1 ? OFF_YB : OFF_YC))) + (long)m0 * 1024;
      const u16* W = (const u16*)(p.ws + OFF_WBR) + ((long)(l * 3 + i) * 1024 + n0) * 1024;
      f32x16 acc[2][1];
      gemm_kloop<1, 1>(acc, A, 1024, W, 1024, 1024, lds);
#pragma unroll
      for (int ni = 0; ni < 2; ++ni)
#pragma unroll
        for (int q = 0; q < 4; ++q) {
          const int n = n0 + wn * 64 + ni * 32 + q * 8 + hi * 4;
          const u32x2 g = *(const u32x2*)(feat + (long)m * NF + F_GATE + i * 1024 + n);
          const float g0 = bflo(g[0]), g1 = bfhi(g[0]), g2 = bflo(g[1]), g3 = bfhi(g[1]);
          if (i == 0) {
            tot[ni][q * 4 + 0] = g0 * acc[ni][0][q * 4 + 0]; tot[ni][q * 4 + 1] = g1 * acc[ni][0][q * 4 + 1];
            tot[ni][q * 4 + 2] = g2 * acc[ni][0][q * 4 + 2]; tot[ni][q * 4 + 3] = g3 * acc[ni][0][q * 4 + 3];
          } else {
            tot[ni][q * 4 + 0] += g0 * acc[ni][0][q * 4 + 0]; tot[ni][q * 4 + 1] += g1 * acc[ni][0][q * 4 + 1];
            tot[ni][q * 4 + 2] += g2 * acc[ni][0][q * 4 + 2]; tot[ni][q * 4 + 3] += g3 * acc[ni][0][q * 4 + 3];
          }
        }
    }
#pragma unroll
    for (int ni = 0; ni < 2; ++ni)
#pragma unroll
      for (int q = 0; q < 4; ++q) {
        const int n = n0 + wn * 64 + ni * 32 + q * 8 + hi * 4;
        st4bf(Y + (long)m * 1024 + n, tot[ni][q * 4 + 0], tot[ni][q * 4 + 1], tot[ni][q * 4 + 2], tot[ni][q * 4 + 3]);
      }
  }
}

DEVI void phase_gemm_res(const Params& p, int ps, int l, int which, char* lds) {
  const int lane = otid() & 63, wid = otid() >> 6, r32 = lane & 31, hi = lane >> 5, wm = wid & 3, wn = wid >> 2;
  const int NTM = tile_ntm(l, 128);
  const bool first = (which == 2);
  const int K = first ? 1024 : FH;
  const u16* Abase = first ? (const u16*)(p.ws + OFF_Y) : (const u16*)(p.ws + OFF_HID);
  const u16* Wbase = first ? ((const u16*)(p.ws + OFF_WOUT) + (long)l * 1024 * 1024) : ((const u16*)(p.ws + OFF_WF2) + (long)l * 1024 * FH);
  for (int tile = vblock(); tile < NTM * 8; tile += gridDim.x) {
    int tm, tn; tile_map(tile, NTM, 8, tm, tn);
    const int m0 = tile_m0(tm, l, 128), n0 = tn * 128;
    f32x16 acc[2][1];
    gemm_kloop<1, 1>(acc, Abase + (long)m0 * K, K, Wbase + (long)n0 * K, K, K, lds);
    const int m = m0 + wm * 32 + r32;
    const float* gv = modvec(p, l, ps, m, which);
    float* dst = xrow(p, ps, m);
    const float* xin = dst;
    if (first && l == 0) xin = inrow(p, ps, m);
#pragma unroll
    for (int ni = 0; ni < 2; ++ni)
#pragma unroll
      for (int q = 0; q < 4; ++q) {
        const int n = n0 + wn * 64 + ni * 32 + q * 8 + hi * 4;
        const f32x4 xi = *(const f32x4*)(xin + n);
        const f32x4 g = *(const f32x4*)(gv + n);
        f32x4 o;
#pragma unroll
        for (int j = 0; j < 4; ++j) o[j] = ALPHA * xi[j] + g[j] * acc[ni][0][q * 4 + j];
        *(f32x4*)(dst + n) = o;
      }
  }
}

DEVI void phase_gemm_f1(const Params& p, int l, char* lds) {
  const u16* H = (const u16*)(p.ws + OFF_H);
  const u16* W = (const u16*)(p.ws + OFF_WF1) + (long)l * 5632 * 1024;
  u16* hid = (u16*)(p.ws + OFF_HID);
  const int lane = otid() & 63, wid = otid() >> 6, r32 = lane & 31, hi = lane >> 5, wm = wid & 3, wn = wid >> 2;
  const int NTM = tile_ntm(l, 256);
  for (int tile = vblock(); tile < NTM * 22; tile += gridDim.x) {
    int tm, tn; tile_map(tile, NTM, 22, tm, tn);
    const int m0 = tile_m0(tm, l, 256), n0 = tn * 256;
    f32x16 acc[4][2];
    __syncthreads();
    gemm_kloop<2, 2>(acc, H + (long)m0 * 1024, 1024, W + (long)n0 * 1024, 1024, 1024, lds);
    char* wl = lds + wid * (64 * 144);
#pragma unroll
    for (int cg2 = 0; cg2 < 2; ++cg2) {
#pragma unroll
      for (int mi = 0; mi < 2; ++mi) {
#pragma unroll
        for (int q = 0; q < 4; ++q) {
          float h[4];
#pragma unroll
          for (int j = 0; j < 4; ++j) h[j] = siluf(acc[2 * cg2][mi][q * 4 + j]) * acc[2 * cg2 + 1][mi][q * 4 + j];
          lds_put4(wl, 144, mi * 32 + r32, cg2 * 32 + q * 8 + hi * 4, h[0], h[1], h[2], h[3]);
        }
      }
    }
    wave_tile_store<64>(wl, hid + (long)(m0 + wm * 64) * FH + (tn * 4 + wn * 2) * 32, FH, lane);
  }
}

DEVI void phase_prep(const Params& p, int l) {
  const int lane = otid() & 63;
  const int gw = blockIdx.x * 8 + (otid() >> 6), nw = gridDim.x * 8;
  const float lam_init = 0.8f - 0.6f * expf(-0.3f * (float)l);
  const float* dl = p.diff_lam + l * 256;
  const float s01 = wave_sum(dl[lane] * dl[64 + lane]), s23 = wave_sum(dl[128 + lane] * dl[192 + lane]);
  const float lam = expf(s01) - expf(s23) + lam_init;
  const u16* feat = (const u16*)(p.ws + OFF_FEAT);
  const u16* og0 = (const u16*)(p.ws + OFF_OG); const u16* og1 = og0 + (long)RP * 1024;
  const u16* od0 = (const u16*)(p.ws + OFF_OD); const u16* od1 = od0 + (long)RP * 1024;
  u16* ya = (u16*)(p.ws + OFF_YA); u16* yb = (u16*)(p.ws + OFF_YB);
  const f32x4 gg = *(const f32x4*)(p.gla_norm_g + l * 256 + lane * 4);
  const float dg0 = p.diff_norm_g[l * 128 + lane * 2] * (1.f - lam_init), dg1 = p.diff_norm_g[l * 128 + lane * 2 + 1] * (1.f - lam_init);
  for (int r = gw; r < RP; r += nw) {
    if (l == 1 && rr_of(r) >= SEQ) continue;
    u32x2 ga[4], gb[4], gr[4]; unsigned da[8], db[8];
#pragma unroll
    for (int u = 0; u < 4; ++u) {
      const long off = (long)r * 1024 + u * 256 + lane * 4;
      ga[u] = *(const u32x2*)(og0 + off); gb[u] = *(const u32x2*)(og1 + off);
      gr[u] = *(const u32x2*)(feat + (long)r * NF + F_GR + u * 256 + lane * 4);
    }
#pragma unroll
    for (int h = 0; h < 8; ++h) {
      const long off = (long)r * 1024 + h * 128 + lane * 2;
      da[h] = *(const unsigned*)(od0 + off); db[h] = *(const unsigned*)(od1 + off);
    }
    float o[4][4], ss[4], e0[8], e1[8], sd[8];
#pragma unroll
    for (int u = 0; u < 4; ++u) {
      o[u][0] = bflo(ga[u][0]) + bflo(gb[u][0]); o[u][1] = bfhi(ga[u][0]) + bfhi(gb[u][0]);
      o[u][2] = bflo(ga[u][1]) + bflo(gb[u][1]); o[u][3] = bfhi(ga[u][1]) + bfhi(gb[u][1]);
      ss[u] = o[u][0] * o[u][0] + o[u][1] * o[u][1] + o[u][2] * o[u][2] + o[u][3] * o[u][3];
    }
#pragma unroll
    for (int h = 0; h < 8; ++h) {
      e0[h] = bflo(da[h]) - lam * bflo(db[h]); e1[h] = bfhi(da[h]) - lam * bfhi(db[h]);
      sd[h] = e0[h] * e0[h] + e1[h] * e1[h];
    }
#pragma unroll
    for (int m = 32; m >= 1; m >>= 1) {
#pragma unroll
      for (int u = 0; u < 4; ++u) ss[u] += __shfl_xor(ss[u], m);
#pragma unroll
      for (int h = 0; h < 8; ++h) sd[h] += __shfl_xor(sd[h], m);
    }
#pragma unroll
    for (int u = 0; u < 4; ++u) {
      const float rsd = rsqrtf(ss[u] * (1.f / 256.f) + EPS);
      const float rv[4] = {bflo(gr[u][0]), bfhi(gr[u][0]), bflo(gr[u][1]), bfhi(gr[u][1])};
      float y[4];
#pragma unroll
      for (int j = 0; j < 4; ++j) y[j] = o[u][j] * rsd * gg[j] * siluf(rv[j]);
      st4bf(ya + (long)r * 1024 + u * 256 + lane * 4, y[0], y[1], y[2], y[3]);
    }
#pragma unroll
    for (int h = 0; h < 8; ++h) {
      const float rsd = rsqrtf(sd[h] * (1.f / 128.f) + EPS);
      *(unsigned*)(yb + (long)r * 1024 + h * 128 + lane * 2) = cvtpk(e0[h] * rsd * dg0, e1[h] * rsd * dg1);
    }
  }
}

DEVI int v_st(int k, int c) { const int kk = (k & ~0xC) | ((k & 4) << 1) | ((k & 8) >> 1); return ((kk >> 3) * 4 + (c >> 5)) * 512 + ((kk & 7) * 32 + (c & 31)) * 2; }
DEVI int v_rd_base(int lane) { return ((lane & 3) << 3) | (((lane >> 2) & 3) << 6) | (((lane >> 4) & 1) << 5) | (((lane >> 5) & 1) << 8); }
constexpr int v_rd_off(int d0, int ks, int half) { return d0 * 512 + ks * 4096 + half * 2048; }
template <int OFF> DEVI s16x4 tr_read(int vb) {
  s16x4 r; asm volatile("ds_read_b64_tr_b16 %0, %1 offset:%2" : "=&v"(r) : "v"(vb), "i"(OFF) : "memory"); return r;
}
template <int D0> DEVI void pv_one(f32x16& od, int vb, bf16x8 pa0, bf16x8 pa1, bf16x8 pa2, bf16x8 pa3) {
  const s16x4 l0 = tr_read<v_rd_off(D0, 0, 0)>(vb), h0 = tr_read<v_rd_off(D0, 0, 1)>(vb), l1 = tr_read<v_rd_off(D0, 1, 0)>(vb), h1 = tr_read<v_rd_off(D0, 1, 1)>(vb);
  const s16x4 l2 = tr_read<v_rd_off(D0, 2, 0)>(vb), h2 = tr_read<v_rd_off(D0, 2, 1)>(vb), l3 = tr_read<v_rd_off(D0, 3, 0)>(vb), h3 = tr_read<v_rd_off(D0, 3, 1)>(vb);
  asm volatile("s_waitcnt lgkmcnt(0)" ::: "memory"); SBAR();
#define PK(L, H) (bf16x8){L[0], L[1], L[2], L[3], H[0], H[1], H[2], H[3]}
  od = __builtin_amdgcn_mfma_f32_32x32x16_bf16(pa0, PK(l0, h0), od, 0, 0, 0);
  od = __builtin_amdgcn_mfma_f32_32x32x16_bf16(pa1, PK(l1, h1), od, 0, 0, 0);
  od = __builtin_amdgcn_mfma_f32_32x32x16_bf16(pa2, PK(l2, h2), od, 0, 0, 0);
  od = __builtin_amdgcn_mfma_f32_32x32x16_bf16(pa3, PK(l3, h3), od, 0, 0, 0);
#undef PK
}
DEVI void pv_d0(f32x16* o, int vb, bf16x8 pa0, bf16x8 pa1, bf16x8 pa2, bf16x8 pa3) {
  pv_one<0>(o[0], vb, pa0, pa1, pa2, pa3); pv_one<1>(o[1], vb, pa0, pa1, pa2, pa3); pv_one<2>(o[2], vb, pa0, pa1, pa2, pa3); pv_one<3>(o[3], vb, pa0, pa1, pa2, pa3);
}
constexpr float ATT_THR = 8.f;
DEVI void partialSM(f32x16& p0, f32x16& p1, float& m_reg, float& mn, float& alpha, float scale) {
  const float C = scale * 1.4426950408889634f;
  float pmax = p0[0];
#pragma unroll
  for (int r = 1; r < 16; ++r) pmax = fmaxf(pmax, p0[r]);
#pragma unroll
  for (int r = 0; r < 16; ++r) pmax = fmaxf(pmax, p1[r]);
  { auto rr = __builtin_amdgcn_permlane32_swap(__float_as_uint(pmax), __float_as_uint(pmax), false, false);
    pmax = fmaxf(__uint_as_float(rr[0]), __uint_as_float(rr[1])); }
  if (__builtin_expect(__all(pmax - m_reg <= ATT_THR / scale), 1)) { mn = m_reg; alpha = 1.f; }
  else { mn = fmaxf(m_reg, pmax); alpha = __builtin_amdgcn_exp2f((m_reg - mn) * C); m_reg = mn; }
  const float mnC = -mn * C;
#pragma unroll
  for (int r = 0; r < 16; ++r) p0[r] = fmaf(p0[r], C, mnC);
#pragma unroll
  for (int r = 0; r < 16; ++r) p1[r] = fmaf(p1[r], C, mnC);
#pragma unroll
  for (int r = 0; r < 16; ++r) p0[r] = __builtin_amdgcn_exp2f(p0[r]);
}
#define PK4(P, BASE, OUT) do { unsigned a0 = cvtpk(P[BASE + 0], P[BASE + 1]), a1 = cvtpk(P[BASE + 2], P[BASE + 3]);   \
    unsigned b0 = cvtpk(P[BASE + 4], P[BASE + 5]), b1 = cvtpk(P[BASE + 6], P[BASE + 7]);                              \
    auto r0 = __builtin_amdgcn_permlane32_swap(a0, b0, false, false); auto r1 = __builtin_amdgcn_permlane32_swap(a1, b1, false, false); \
    u32x4 w = {r0[0], r1[0], r0[1], r1[1]}; OUT = *reinterpret_cast<bf16x8*>(&w); } while (0)
DEVI void finishSM(f32x16& p0, f32x16& p1, float alpha, float& l_reg, bf16x8& pa0, bf16x8& pa1, bf16x8& pa2, bf16x8& pa3) {
#pragma unroll
  for (int r = 0; r < 16; ++r) p1[r] = __builtin_amdgcn_exp2f(p1[r]);
  float ps = 0;
#pragma unroll
  for (int r = 0; r < 16; ++r) ps += p0[r];
#pragma unroll
  for (int r = 0; r < 16; ++r) ps += p1[r];
  { auto rr = __builtin_amdgcn_permlane32_swap(__float_as_uint(ps), __float_as_uint(ps), false, false);
    ps = __uint_as_float(rr[0]) + __uint_as_float(rr[1]); }
  l_reg = l_reg * alpha + ps;
  PK4(p0, 0, pa0); PK4(p0, 8, pa1); PK4(p1, 0, pa2); PK4(p1, 8, pa3);
}

template <int DQK, bool PIPE>
DEVI void attn_body(const u16* __restrict__ Qb, int ldq, const u16* __restrict__ K0, int ldk0, const u16* __restrict__ K1, int ldk1,
                    const u16* __restrict__ Vh, int ldv, u16* __restrict__ Ob, int ldo, int seq, float scale, char* lds) {
  constexpr int KRB = DQK * 2, SHM_K = 64 * KRB, SHM_V = 16384, ND0 = DQK / 16, NCH = DQK / 8, NKC = (64 * NCH) / NTHREADS;
  const int tid = otid(), wid = tid >> 6, lane = tid & 63, r32 = lane & 31, hi = lane >> 5;
  char* V_lds = lds; char* K_lds = lds + 2 * SHM_V;
  float* wsf = (float*)(lds + 2 * SHM_V + 2 * SHM_K) + wid * 64; float* li_l = wsf; float* al_l = wsf + 32;
  float m_reg = -1e30f, l_reg = 0; f32x16 o[4];
#pragma unroll
  for (int d = 0; d < 4; ++d)
#pragma unroll
    for (int r = 0; r < 16; ++r) o[d][r] = 0.f;
  bf16x8 qr[ND0];
  const u16* Qw = Qb + (long)(wid * 32 + r32) * ldq + hi * 8;
#pragma unroll
  for (int d0 = 0; d0 < ND0; ++d0) qr[d0] = *(const bf16x8*)(Qw + d0 * 16);
  const int sr = tid >> 4, sc = (tid & 15) * 8, vst0 = v_st(sr, sc), vst1 = v_st(32 + sr, sc);
  const int vb0 = (int)(uintptr_t)V_lds + v_rd_base(lane);
  bf16x8 vs0, vs1, ksg[NKC];
  const int krow0 = (DQK == 64) ? (tid >> 3) : (tid >> 4), kchk0 = (DQK == 64) ? (tid & 7) : (tid & 15);
  const u16* kp0 = K0 + (long)krow0 * ldk0 + kchk0 * 8;
  const int koff0 = krow0 * KRB + ((kchk0 * 16) ^ (((krow0 >> 1) & 7) << 4));
  const int koff1 = (krow0 + 32) * KRB + ((kchk0 * 16) ^ (((krow0 >> 1) & 7) << 4));
  const int krow2 = tid >> 3, kchk2 = 16 + (tid & 7);
  const u16* kp2 = K1 + (long)krow2 * ldk1 + (tid & 7) * 8;
  const int koff2 = krow2 * KRB + ((kchk2 * 16) ^ (((krow2 >> 1) & 7) << 4));
  const u16* vp0 = Vh + (long)sr * ldv + sc;
#define SLOAD(k0) do { vs0 = *(const bf16x8*)(vp0 + (long)(k0) * ldv); vs1 = *(const bf16x8*)(vp0 + (long)((k0) + 32) * ldv); \
    ksg[0] = *(const bf16x8*)(kp0 + (long)(k0) * ldk0); \
    if constexpr (DQK == 192) { ksg[1] = *(const bf16x8*)(kp0 + (long)((k0) + 32) * ldk0); ksg[2] = *(const bf16x8*)(kp2 + (long)(k0) * ldk1); } } while (0)
#define SWRITE(b) do { *(bf16x8*)(V_lds + (b) * SHM_V + vst0) = vs0; *(bf16x8*)(V_lds + (b) * SHM_V + vst1) = vs1; \
    *(bf16x8*)(K_lds + (b) * SHM_K + koff0) = ksg[0]; \
    if constexpr (DQK == 192) { *(bf16x8*)(K_lds + (b) * SHM_K + koff1) = ksg[1]; *(bf16x8*)(K_lds + (b) * SHM_K + koff2) = ksg[2]; } } while (0)
#define SWAIT() asm volatile("s_waitcnt vmcnt(0)" ::: "memory")
#define RESC(a) do { if (__any((a) < 1.f)) { if (hi == 0) al_l[r32] = (a); asm volatile("s_waitcnt lgkmcnt(0)" ::: "memory"); \
    _Pragma("unroll") for (int d = 0; d < 4; ++d) _Pragma("unroll") for (int r = 0; r < 16; ++r) o[d][r] *= al_l[crow(r, hi)]; } } while (0)
#define QKT(P0, P1, KB) do { _Pragma("unroll") for (int r_ = 0; r_ < 16; ++r_) { P0[r_] = 0.f; P1[r_] = 0.f; } \
    _Pragma("unroll") for (int d0 = 0; d0 < ND0; ++d0) { const int cb_ = (d0 * 16 + hi * 8) * 2; \
      bf16x8 b0_ = *(const bf16x8*)((KB) + r32 * KRB + (cb_ ^ (((r32 >> 1) & 7) << 4))); \
      bf16x8 b1_ = *(const bf16x8*)((KB) + (32 + r32) * KRB + (cb_ ^ (((r32 >> 1) & 7) << 4))); \
      P0 = __builtin_amdgcn_mfma_f32_32x32x16_bf16(b0_, qr[d0], P0, 0, 0, 0); \
      P1 = __builtin_amdgcn_mfma_f32_32x32x16_bf16(b1_, qr[d0], P1, 0, 0, 0); } } while (0)
  bf16x8 pa0, pa1, pa2, pa3; const int NT = seq / 64;
  if constexpr (PIPE) {
    f32x16 pA0, pA1, pB0, pB1; float mnA, mnB, alA, alB;
    SLOAD(0); SWAIT(); SWRITE(0); __syncthreads();
    QKT(pA0, pA1, K_lds); partialSM(pA0, pA1, m_reg, mnA, alA, scale);
    SLOAD(64);
    SWAIT(); SWRITE(1); __syncthreads();
    for (int j = 1; j + 1 < NT; j += 2) {
      SBAR(); QKT(pB0, pB1, K_lds + SHM_K);
      finishSM(pA0, pA1, alA, l_reg, pa0, pa1, pa2, pa3); SBAR();
      SLOAD((j + 1) * 64); SBAR();
      pv_d0(o, vb0, pa0, pa1, pa2, pa3); partialSM(pB0, pB1, m_reg, mnB, alB, scale);
      __syncthreads(); SWAIT(); SWRITE(0);
      RESC(alB); __syncthreads();
      SBAR(); QKT(pA0, pA1, K_lds);
      finishSM(pB0, pB1, alB, l_reg, pa0, pa1, pa2, pa3); SBAR();
      SLOAD((j + 2) * 64); SBAR();
      pv_d0(o, vb0 + SHM_V, pa0, pa1, pa2, pa3); partialSM(pA0, pA1, m_reg, mnA, alA, scale);
      __syncthreads(); SWAIT(); SWRITE(1);
      RESC(alA); __syncthreads();
    }
    SBAR(); QKT(pB0, pB1, K_lds + SHM_K);
    finishSM(pA0, pA1, alA, l_reg, pa0, pa1, pa2, pa3); SBAR();
    pv_d0(o, vb0, pa0, pa1, pa2, pa3); partialSM(pB0, pB1, m_reg, mnB, alB, scale);
    __syncthreads(); RESC(alB);
    finishSM(pB0, pB1, alB, l_reg, pa0, pa1, pa2, pa3); SBAR();
    pv_d0(o, vb0 + SHM_V, pa0, pa1, pa2, pa3);
  } else {
    f32x16 p0, p1; float mn, al;
    SLOAD(0); SWAIT(); SWRITE(0); __syncthreads();
    for (int j = 0; j < NT; ++j) {
      const int bsel = j & 1;
      if (j + 1 < NT) SLOAD((j + 1) * 64);
      SBAR(); QKT(p0, p1, K_lds + bsel * SHM_K);
      partialSM(p0, p1, m_reg, mn, al, scale);
      RESC(al);
      finishSM(p0, p1, al, l_reg, pa0, pa1, pa2, pa3); SBAR();
      pv_d0(o, vb0 + bsel * SHM_V, pa0, pa1, pa2, pa3);
      if (j + 1 < NT) { SWAIT(); SWRITE(bsel ^ 1); }
      __syncthreads();
    }
  }
  if (hi == 0) li_l[r32] = l_reg; asm volatile("s_waitcnt lgkmcnt(0)" ::: "memory");
  float rli[16];
#pragma unroll
  for (int r = 0; r < 16; ++r) rli[r] = __builtin_amdgcn_rcpf(li_l[crow(r, hi)]);
  u16* Ow = Ob + (long)(wid * 32) * ldo;
#pragma unroll
  for (int r = 0; r < 16; ++r) { const int orow = crow(r, hi);
#pragma unroll
    for (int d0 = 0; d0 < 4; ++d0) Ow[(long)orow * ldo + d0 * 32 + r32] = f2bf(o[d0][r] * rli[r]); }
  __syncthreads();
#undef SLOAD
#undef SWRITE
#undef SWAIT
#undef RESC
#undef QKT
}

DEVI long gla_row(int bi, int dir, int cc, int i) {
  const int L = (cc < 4) ? CTXL : SEQ, c = (cc < 4) ? cc : cc - 4, rb = bi * ROWS + ((cc < 4) ? SEQ : 0);
  const int tl = c * 64 + i;
  return (long)(rb + (dir ? (L - 1 - tl) : tl));
}
DEVI void gla_seq(const Params& p, int l, int item, char* lds) {
  const int tid = otid(), wid = tid >> 6, lane = tid & 63, r32 = lane & 31, hi = lane >> 5;
  const int bi = item >> 5, h = (item >> 3) & 3, dir = (item >> 2) & 1, sl = item & 3;
  char* qs = lds;
  char* ks = lds + 16384;
  char* kT = lds + 32768;
  char* vT = lds + 32768 + 18432;
  char* sT = lds + 32768 + 18432 + 9216;
  float* gas = (float*)(sT + 32768);
  float* segtot = gas + 1024;
  float* ebl = segtot + 512;
  const u16* feat = (const u16*)(p.ws + OFF_FEAT);
  u16* og = (u16*)(p.ws + OFF_OG) + (long)dir * RP * 1024;
  const int d = tid & 127, seg = tid >> 7;
  float w2[16];
#pragma unroll
  for (int r = 0; r < 16; ++r) w2[r] = p.gla_w_a2[(((long)l * 2 + dir) * 16 + r) * 512 + h * 128 + d];
  const float ba = p.gla_b_a[((long)l * 2 + dir) * 512 + h * 128 + d];
  __syncthreads();
  for (int i = tid; i < 8192; i += NTHREADS) ((unsigned*)sT)[i] = 0u;
  f32x16 Sacc;
#pragma unroll
  for (int r = 0; r < 16; ++r) Sacc[r] = 0.f;
  const int dblk = wid >> 1, eblk = wid & 1, iblk = (wid >> 1) & 1;
  u32x4 pq0, pq1, pk0, pk1, pv; u16 pg0, pg1;
  const int row0 = tid >> 4, chq = tid & 15;
  const int vi0 = tid >> 3, ve8 = (tid & 7) * 8;
  const int g0i = (tid * 2) >> 4, g0r = (tid * 2) & 15;
#define GLOADC(cc_) do { \
    const u16* f0_ = feat + gla_row(bi, dir, (cc_), row0) * NF + h * 128 + chq * 8; \
    const u16* f1_ = feat + gla_row(bi, dir, (cc_), 32 + row0) * NF + h * 128 + chq * 8; \
    pq0 = *(const u32x4*)(f0_ + F_GQ); pk0 = *(const u32x4*)(f0_ + F_GK); pq1 = *(const u32x4*)(f1_ + F_GQ); pk1 = *(const u32x4*)(f1_ + F_GK); \
    pv = *(const u32x4*)(feat + gla_row(bi, dir, (cc_), vi0) * NF + F_GV + h * 256 + sl * 64 + ve8); \
    const u16* g_ = feat + gla_row(bi, dir, (cc_), g0i) * NF + F_GA + dir * 16 + g0r; pg0 = g_[0]; pg1 = g_[1]; } while (0)
  GLOADC(0);
  int cur = 0;
  for (int cc = 0; cc < 132; ++cc) {
    {
      const int so0 = row0 * 256 + ((chq ^ (row0 & 7)) << 4), so1 = so0 + 32 * 256;
      *(u32x4*)(qs + so0) = pq0; *(u32x4*)(ks + so0) = pk0; *(u32x4*)(qs + so1) = pq1; *(u32x4*)(ks + so1) = pk1;
#pragma unroll
      for (int j = 0; j < 4; ++j) {
        *(u16*)(vT + (ve8 + 2 * j) * 144 + vi0 * 2) = (u16)(pv[j] & 0xffffu);
        *(u16*)(vT + (ve8 + 2 * j + 1) * 144 + vi0 * 2) = (u16)(pv[j] >> 16);
      }
      gas[tid * 2] = bf2f(pg0); gas[tid * 2 + 1] = bf2f(pg1);
    }
    __syncthreads();
    if (cc + 1 < 132) GLOADC(cc + 1);
    SBAR();
    float bcum[16];
    {
      float run = 0.f;
#pragma unroll
      for (int ii = 0; ii < 16; ++ii) {
        const float* gr_ = gas + (seg * 16 + ii) * 16;
        float z = ba;
#pragma unroll
        for (int r = 0; r < 16; ++r) z += gr_[r] * w2[r];
        const float ls = fminf(z, 0.f) - __logf(1.f + __expf(-fabsf(z)));
        run += ls * (1.f / 16.f);
        bcum[ii] = run;
      }
      segtot[seg * 128 + d] = run;
    }
    __syncthreads();
    {
      float pre = 0.f, tot = 0.f;
#pragma unroll
      for (int s_ = 0; s_ < 4; ++s_) { const float v = segtot[s_ * 128 + d]; tot += v; if (s_ < seg) pre += v; }
      const float etot = __expf(tot);
      if (seg == 0) ebl[d] = etot;
#pragma unroll
      for (int ii = 0; ii < 16; ++ii) {
        const int i = seg * 16 + ii;
        const float bb = bcum[ii] + pre;
        const int so = i * 256 + (((d >> 3) ^ (i & 7)) << 4) + (d & 7) * 2;
        const float q = bf2f(*(const u16*)(qs + so)), k = bf2f(*(const u16*)(ks + so));
        const float eb = __expf(bb), ieb = __frcp_rn(eb);
        *(u16*)(qs + so) = f2bf(q * eb);
        *(u16*)(ks + so) = f2bf(k * ieb);
        *(u16*)(kT + d * 144 + i * 2) = f2bf(k * (etot * ieb));
      }
    }
    __syncthreads();
    const char* sTc = sT + cur * 16384; char* sTn = sT + (cur ^ 1) * 16384;
    if (wid < 4) {
      f32x16 p0, p1, o;
#pragma unroll
      for (int r = 0; r < 16; ++r) { p0[r] = 0.f; p1[r] = 0.f; o[r] = 0.f; }
      const int irow = iblk * 32 + r32;
#pragma unroll
      for (int d0 = 0; d0 < 8; ++d0) {
        const int chn = d0 * 2 + hi;
        const bf16x8 b0 = *(const bf16x8*)(ks + r32 * 256 + ((chn ^ (r32 & 7)) << 4));
        const bf16x8 b1 = *(const bf16x8*)(ks + (32 + r32) * 256 + ((chn ^ (r32 & 7)) << 4));
        const bf16x8 qf = *(const bf16x8*)(qs + irow * 256 + ((chn ^ (irow & 7)) << 4));
        p0 = __builtin_amdgcn_mfma_f32_32x32x16_bf16(b0, qf, p0, 0, 0, 0);
        p1 = __builtin_amdgcn_mfma_f32_32x32x16_bf16(b1, qf, p1, 0, 0, 0);
      }
#pragma unroll
      for (int r = 0; r < 16; ++r) {
        const int j0 = crow(r, hi), j1 = 32 + j0;
        const bool k0 = dir ? (j0 < irow) : (j0 <= irow), k1 = dir ? (j1 < irow) : (j1 <= irow);
        p0[r] = k0 ? p0[r] : 0.f; p1[r] = k1 ? p1[r] : 0.f;
      }
      bf16x8 pa0, pa1, pa2, pa3;
      PK4(p0, 0, pa0); PK4(p0, 8, pa1); PK4(p1, 0, pa2); PK4(p1, 8, pa3);
      const char* vrow = vT + (eblk * 32 + r32) * 144 + hi * 16;
      o = __builtin_amdgcn_mfma_f32_32x32x16_bf16(pa0, *(const bf16x8*)(vrow), o, 0, 0, 0);
      o = __builtin_amdgcn_mfma_f32_32x32x16_bf16(pa1, *(const bf16x8*)(vrow + 32), o, 0, 0, 0);
      o = __builtin_amdgcn_mfma_f32_32x32x16_bf16(pa2, *(const bf16x8*)(vrow + 64), o, 0, 0, 0);
      o = __builtin_amdgcn_mfma_f32_32x32x16_bf16(pa3, *(const bf16x8*)(vrow + 96), o, 0, 0, 0);
      const int erow = eblk * 32 + r32;
#pragma unroll
      for (int d0 = 0; d0 < 8; ++d0) {
        const int chn = d0 * 2 + hi;
        const bf16x8 qf = *(const bf16x8*)(qs + irow * 256 + ((chn ^ (irow & 7)) << 4));
        const bf16x8 sf = *(const bf16x8*)(sTc + erow * 256 + ((chn ^ (erow & 7)) << 4));
        o = __builtin_amdgcn_mfma_f32_32x32x16_bf16(qf, sf, o, 0, 0, 0);
      }
#pragma unroll
      for (int r = 0; r < 16; ++r)
        og[gla_row(bi, dir, cc, iblk * 32 + crow(r, hi)) * 1024 + h * 256 + sl * 64 + eblk * 32 + r32] = f2bf(o[r]);
    }
    {
#pragma unroll
      for (int r = 0; r < 16; ++r) Sacc[r] *= ebl[dblk * 32 + crow(r, hi)];
      const char* krow = kT + (dblk * 32 + r32) * 144 + hi * 16;
      const char* vrow = vT + (eblk * 32 + r32) * 144 + hi * 16;
#pragma unroll
      for (int k16 = 0; k16 < 4; ++k16)
        Sacc = __builtin_amdgcn_mfma_f32_32x32x16_bf16(*(const bf16x8*)(krow + k16 * 32), *(const bf16x8*)(vrow + k16 * 32), Sacc, 0, 0, 0);
      const int erow = eblk * 32 + r32;
#pragma unroll
      for (int q4 = 0; q4 < 4; ++q4) {
        const int chn = dblk * 4 + q4;
        u32x2 w = {cvtpk(Sacc[q4 * 4 + 0], Sacc[q4 * 4 + 1]), cvtpk(Sacc[q4 * 4 + 2], Sacc[q4 * 4 + 3])};
        *(u32x2*)(sTn + erow * 256 + ((chn ^ (erow & 7)) << 4) + hi * 8) = w;
      }
    }
    cur ^= 1;
    __syncthreads();
  }
#undef GLOADC
}

DEVI void phase_mix(const Params& p, int ps, int l, char* lds) {
  __shared__ int s_q;
  const u16* feat = (const u16*)(p.ws + OFF_FEAT);
  const u16* qm = (const u16*)(p.ws + OFF_QM);
  const u16* kvb = (const u16*)(p.ws + OFF_KV);
  u16* od = (u16*)(p.ws + OFF_OD);
  u16* yc = (u16*)(p.ws + OFF_YC);
  const int x = blockIdx.x & 7, jb = blockIdx.x >> 3;
  if (jb < 8) gla_seq(p, l, x * 8 + jb, lds);
  int* ctr = (int*)(p.ws + OFF_CTR) + 128 + (ps * 2 + l) * 8 + x;
  const int nmla = NBP * 32, ndiff = NBP * 64, nctx = (l == 0) ? (NBP * 24 / 8) : 0;
  for (;;) {
    __syncthreads();
    if (otid() == 0) s_q = atomicAdd(ctr, 1);
    __syncthreads();
    const int q = s_q;
    if (q >= nmla) break;
    const int bi = q >> 5, h = x, q0 = bi * ROWS + (q & 31) * 256;
    const long k0 = (long)bi * ROWS;
    attn_body<192, false>(qm + (long)q0 * 1536 + h * 192, 1536, kvb + k0 * 2048 + h * 256, 2048, feat + k0 * NF + F_KR, NF,
                          kvb + k0 * 2048 + h * 256 + 128, 2048, yc + (long)q0 * 1024 + h * 128, 1024, ROWS, 0.07216878364870322f, lds);
  }
  int* ctr2 = ctr + 128;
  for (;;) {
    __syncthreads();
    if (otid() == 0) s_q = atomicAdd(ctr2, 1);
    __syncthreads();
    const int q = s_q;
    if (q >= ndiff + nctx) break;
    if (q < ndiff) {
      const int bi = q >> 6, hm = 2 * x + ((q >> 5) & 1), h = hm >> 1, mp = hm & 1, q0 = bi * ROWS + (q & 31) * 256;
      const long k0 = (long)bi * ROWS;
      attn_body<64, true>(feat + (long)q0 * NF + F_DQ + h * 128 + mp * 64, NF, feat + k0 * NF + F_DK + h * 128 + mp * 64, NF, feat, NF,
                          feat + k0 * NF + F_DV + h * 128, NF, od + (long)mp * RP * 1024 + (long)q0 * 1024 + h * 128, 1024, ROWS, 0.125f, lds);
    } else {
      const int u = (q - ndiff) * 8 + x, bi = u / 24, v = u % 24;
      const long c0 = (long)bi * ROWS + SEQ;
      if (v < 8) {
        const int h = v;
        attn_body<192, false>(qm + c0 * 1536 + h * 192, 1536, kvb + c0 * 2048 + h * 256, 2048, feat + c0 * NF + F_KR, NF,
                              kvb + c0 * 2048 + h * 256 + 128, 2048, yc + c0 * 1024 + h * 128, 1024, CTXL, 0.07216878364870322f, lds);
      } else {
        const int h = (v - 8) >> 1, mp = (v - 8) & 1;
        attn_body<64, true>(feat + c0 * NF + F_DQ + h * 128 + mp * 64, NF, feat + c0 * NF + F_DK + h * 128 + mp * 64, NF, feat, NF,
                            feat + c0 * NF + F_DV + h * 128, NF, od + (long)mp * RP * 1024 + c0 * 1024 + h * 128, 1024, CTXL, 0.125f, lds);
      }
    }
  }
}

DEVI void grid_bar(unsigned* ctr, unsigned& epoch) {
  asm volatile("s_waitcnt vmcnt(0)" ::: "memory");
  __syncthreads();
  if (threadIdx.x == 0) {
    __builtin_amdgcn_fence(__ATOMIC_RELEASE, "agent");
    asm volatile("s_waitcnt vmcnt(0)" ::: "memory");
    __hip_atomic_fetch_add(ctr, 1u, __ATOMIC_RELAXED, __HIP_MEMORY_SCOPE_AGENT);
    const unsigned target = (epoch + 1u) * gridDim.x;
    while (__hip_atomic_load(ctr, __ATOMIC_RELAXED, __HIP_MEMORY_SCOPE_AGENT) < target) __builtin_amdgcn_s_sleep(1);
    __builtin_amdgcn_fence(__ATOMIC_ACQUIRE, "agent");
    asm volatile("s_waitcnt vmcnt(0)" ::: "memory");
  }
  __syncthreads();
  ++epoch;
}

__global__ void __launch_bounds__(NTHREADS) fwd_megakernel(Params p) {
  extern __shared__ __attribute__((aligned(16))) char lds[];
  cg::grid_group grid = cg::this_grid();
  if (blockIdx.x == 0) ((int*)(p.ws + OFF_CTR))[threadIdx.x] = 0;
  unsigned* gbar = (unsigned*)(p.ws + OFF_CTR) + 96; unsigned epoch = 0;
  for (int l = 0; l < 2; ++l) {
    conv_weight(p.w_in + (long)l * 1024 * NIN_ORIG, NIN_ORIG, (u16*)(p.ws + OFF_WIN) + (long)l * NF * 1024, NF, 1024, 1, nullptr, lds);
    conv_weight(p.mla_w_uq + (long)l * 256 * 1536, 1536, (u16*)(p.ws + OFF_WUQ) + (long)l * 1536 * 256, 1536, 256, 0, p.mla_q_norm_g + l * 256, lds);
    conv_weight(p.mla_w_ukv + (long)l * 128 * 2048, 2048, (u16*)(p.ws + OFF_WUKV) + (long)l * 2048 * 128, 2048, 128, 0, p.mla_kv_norm_g + l * 128, lds);
    for (int i = 0; i < 3; ++i)
      conv_weight(p.w_branch + ((long)l * 3 + i) * 1024 * 1024, 1024, (u16*)(p.ws + OFF_WBR) + ((long)l * 3 + i) * 1024 * 1024, 1024, 1024, 0, nullptr, lds);
    conv_weight(p.w_out + (long)l * 1024 * 1024, 1024, (u16*)(p.ws + OFF_WOUT) + (long)l * 1024 * 1024, 1024, 1024, 0, nullptr, lds);
    conv_weight(p.ffn_w_in + (long)l * 1024 * 5632, 5632, (u16*)(p.ws + OFF_WF1) + (long)l * 5632 * 1024, 5632, 1024, 2, nullptr, lds);
    conv_weight(p.ffn_w_out + (long)l * FH * 1024, 1024, (u16*)(p.ws + OFF_WF2) + (long)l * 1024 * FH, 1024, FH, 0, nullptr, lds);
  }
  phase_modv(p, lds);
  phase_rope(p);
  grid.sync();
  phase_mod1_l0(p, 0);
  grid_bar(gbar, epoch);
  for (int ps = 0; ps < NPASS; ++ps) {
    for (int l = 0; l < 2; ++l) {
      phase_gemm_in(p, l, lds);              grid_bar(gbar, epoch);
      phase_gemm_up(p, l, lds);              grid_bar(gbar, epoch);
      phase_mix(p, ps, l, lds);              grid_bar(gbar, epoch);
      phase_prep(p, l);                      grid_bar(gbar, epoch);
      phase_gemm_br(p, l, lds);              grid_bar(gbar, epoch);
      phase_gemm_res(p, ps, l, 2, lds);      grid_bar(gbar, epoch);
      phase_rows_a(p, ps, l);                grid_bar(gbar, epoch);
      phase_gemm_f1(p, l, lds);              grid_bar(gbar, epoch);
      phase_gemm_res(p, ps, l, 5, lds);      grid_bar(gbar, epoch);
      phase_rows_b(p, ps, l);                if (!(ps == NPASS - 1 && l == 1)) grid_bar(gbar, epoch);
    }
  }
}

extern "C" void kernel_launch(void* const* d_in, const int* in_sizes, int n_in, void* d_out, int out_size, void* d_ws, size_t ws_size, hipStream_t stream) {
  static int grid_blocks = 0;
  if (grid_blocks == 0) {
    if (n_in != 24 || ws_size < WS_END) { fprintf(stderr, "kernel_launch: n_in %d ws %zu need %zu\n", n_in, ws_size, (size_t)WS_END); grid_blocks = -1; return; }
    int dev = 0, cus = 0, per_cu = 0;
    hipGetDevice(&dev);
    hipDeviceGetAttribute(&cus, hipDeviceAttributeMultiprocessorCount, dev);
    if (hipFuncSetAttribute((const void*)fwd_megakernel, hipFuncAttributeMaxDynamicSharedMemorySize, LDS_BYTES) != hipSuccess) { fprintf(stderr, "kernel_launch: LDS attr failed\n"); grid_blocks = -1; return; }
    hipOccupancyMaxActiveBlocksPerMultiprocessor(&per_cu, (const void*)fwd_megakernel, NTHREADS, LDS_BYTES);
    if (per_cu < 1) { fprintf(stderr, "kernel_launch: occupancy %d\n", per_cu); per_cu = 1; }
    if (per_cu > 1) per_cu = 1;
    grid_blocks = cus * per_cu;
  }
  if (grid_blocks < 0) return;
  Params p{};
  const float** pp = (const float**)&p;
  for (int i = 0; i < 24; ++i) pp[i] = (const float*)d_in[i];
  p.out = (float*)d_out; p.ws = (char*)d_ws;
  void* args[] = {&p};
  hipError_t e = hipLaunchCooperativeKernel((const void*)fwd_megakernel, dim3(grid_blocks), dim3(NTHREADS), args, LDS_BYTES, stream);
  if (e != hipSuccess) fprintf(stderr, "cooperative launch failed: %s (grid %d)\n", hipGetErrorString(e), grid_blocks);
}
```

```cpp
#include <hip/hip_runtime.h>
#include <hip/hip_bf16.h>
#include <hip/hip_cooperative_groups.h>
#include <cstdio>
#include <cstdint>
namespace cg = cooperative_groups;

#define DEVI __device__ __forceinline__
typedef unsigned short u16;
typedef __attribute__((ext_vector_type(8))) short bf16x8;
typedef __attribute__((ext_vector_type(4))) short s16x4;
typedef __attribute__((ext_vector_type(16))) float f32x16;
typedef __attribute__((ext_vector_type(4))) float f32x4;
typedef __attribute__((ext_vector_type(4))) unsigned u32x4;
typedef __attribute__((ext_vector_type(2))) unsigned u32x2;

constexpr int DM = 1024, NBATCH = 8, SEQ = 8192, CTXL = 256, ROWS = SEQ + CTXL;
constexpr int NF = 9728;
constexpr int F_GQ = 0, F_GK = 512, F_GV = 1024, F_GR = 2048, F_DQ = 3072, F_DK = 4096, F_DV = 5120, F_MQ = 6144, F_MKV = 6400,
              F_GATE = 6528, F_KR = 9600, F_GA = 9664;
constexpr int FH = 2816;
constexpr int NIN_ORIG = 9696;
constexpr float ALPHA = 1.4142135623730951f;
constexpr float EPS = 1e-6f;
constexpr int NTHREADS = 512;
constexpr int NBP = 2, RP = NBP * ROWS, NPASS = NBATCH / NBP;

constexpr size_t al256(size_t x) { return (x + 255) / 256 * 256; }
constexpr size_t OFF_WIN  = 0;
constexpr size_t OFF_WUQ  = OFF_WIN  + al256((size_t)2 * NF * 1024 * 2);
constexpr size_t OFF_WUKV = OFF_WUQ  + al256((size_t)2 * 1536 * 256 * 2);
constexpr size_t OFF_WBR  = OFF_WUKV + al256((size_t)2 * 2048 * 128 * 2);
constexpr size_t OFF_WOUT = OFF_WBR  + al256((size_t)2 * 3 * 1024 * 1024 * 2);
constexpr size_t OFF_WF1  = OFF_WOUT + al256((size_t)2 * 1024 * 1024 * 2);
constexpr size_t OFF_WF2  = OFF_WF1  + al256((size_t)2 * 5632 * 1024 * 2);
constexpr size_t OFF_MODV = OFF_WF2  + al256((size_t)2 * 1024 * 2816 * 2);
constexpr size_t OFF_ROPE = OFF_MODV + al256((size_t)2 * 9 * 6144 * 4);
constexpr size_t OFF_CTR  = OFF_ROPE + al256((size_t)SEQ * 64 * 4);
constexpr size_t OFF_XC   = OFF_CTR  + 2048;
constexpr size_t OFF_H    = OFF_XC   + al256((size_t)NBP * CTXL * 1024 * 4);
constexpr size_t OFF_FEAT = OFF_H    + al256((size_t)RP * 1024 * 2);
constexpr size_t OFF_QM   = OFF_FEAT + al256((size_t)RP * NF * 2);
constexpr size_t OFF_KV   = OFF_QM   + al256((size_t)RP * 1536 * 2);
constexpr size_t OFF_OG   = OFF_KV   + al256((size_t)RP * 2048 * 2);
constexpr size_t OFF_OD   = OFF_OG   + al256((size_t)2 * RP * 1024 * 2);
constexpr size_t OFF_YC   = OFF_OD   + al256((size_t)2 * RP * 1024 * 2);
constexpr size_t WS_END   = OFF_YC   + al256((size_t)RP * 1024 * 2);
constexpr size_t OFF_YA   = OFF_OG;
constexpr size_t OFF_YB   = OFF_OD;
constexpr size_t OFF_Y    = OFF_H;
constexpr size_t OFF_HID  = OFF_FEAT;

constexpr int LDS_BYTES = 140 * 1024;

struct Params {
  const float *x, *c, *ctx, *c_ctx, *w_mod, *b_mod, *w_in, *gla_w_a2, *gla_b_a, *gla_norm_g, *diff_lam, *diff_norm_g,
      *mla_q_norm_g, *mla_kv_norm_g, *mla_w_uq, *mla_w_ukv, *w_branch, *w_out, *ln1_g, *ln1_b, *ffn_w_in, *ffn_w_out, *ln2_g, *ln2_b;
  float* out;
  char* ws;
};

typedef float f32x2_t __attribute__((ext_vector_type(2)));
typedef __bf16 bf16x2_t __attribute__((ext_vector_type(2)));
DEVI unsigned cvtpk(float lo, float hi) { f32x2_t v = {lo, hi}; bf16x2_t b = __builtin_convertvector(v, bf16x2_t); return __builtin_bit_cast(unsigned, b); }
DEVI u16 f2bf(float f) { return (u16)(cvtpk(f, 0.f) & 0xffffu); }
DEVI float bf2f(u16 h) { return __uint_as_float(((unsigned)h) << 16); }
DEVI float bflo(unsigned w) { return __uint_as_float(w << 16); }
DEVI float bfhi(unsigned w) { return __uint_as_float(w & 0xffff0000u); }
DEVI void st4bf(u16* p, float a, float b, float c, float d) { u32x2 w = {cvtpk(a, b), cvtpk(c, d)}; *(u32x2*)p = w; }
DEVI float wave_sum(float v) {
#pragma unroll
  for (int m = 32; m >= 1; m >>= 1) v += __shfl_xor(v, m);
  return v;
}
DEVI float siluf(float x) { return x / (1.f + expf(-x)); }
DEVI float sigmf(float x) { return 1.f / (1.f + expf(-x)); }
DEVI int crow(int r, int hi) { return (r & 3) + 8 * (r >> 2) + 4 * hi; }
#define SBAR() __builtin_amdgcn_sched_barrier(0)

DEVI int vblock() { return (int)(blockIdx.x & 7) * (int)(gridDim.x >> 3) + (int)(blockIdx.x >> 3); }
DEVI void tile_map(int t, int NTM, int NTN, int& tm, int& tn) {
  const int per = NTM * 4, g = t / per, r = t - g * per;
  const int w = (NTN - g * 4) < 4 ? (NTN - g * 4) : 4;
  tm = r / w; tn = g * 4 + (r - tm * w);
}
DEVI int otid() { int t = threadIdx.x; asm volatile("" : "+v"(t)); return t; }

template <int MI, int NC>
DEVI void mfma_tile(f32x16 (&acc)[2 * NC][MI], const char* Ab, const char* Bb, int rowa0, int rowb0, int sa, int sb, int hi) {
  if constexpr (MI * NC >= 4) {
#pragma unroll
    for (int k16 = 0; k16 < 4; ++k16) {
      const int chn = k16 * 2 + hi;
      bf16x8 ga[2 * NC], gb[MI];
#pragma unroll
      for (int ni = 0; ni < 2 * NC; ++ni) ga[ni] = *(const bf16x8*)(Bb + (rowa0 + 32 * ni) * 128 + ((chn ^ sa) << 4));
#pragma unroll
      for (int mi = 0; mi < MI; ++mi) gb[mi] = *(const bf16x8*)(Ab + (rowb0 + 32 * mi) * 128 + ((chn ^ sb) << 4));
#pragma unroll
      for (int ni = 0; ni < 2 * NC; ++ni)
#pragma unroll
        for (int mi = 0; mi < MI; ++mi)
          acc[ni][mi] = __builtin_amdgcn_mfma_f32_32x32x16_bf16(ga[ni], gb[mi], acc[ni][mi], 0, 0, 0);
    }
    return;
  }
  bf16x8 fa[2][2 * NC], fb[2][MI];
#pragma unroll
  for (int ni = 0; ni < 2 * NC; ++ni) fa[0][ni] = *(const bf16x8*)(Bb + (rowa0 + 32 * ni) * 128 + ((hi ^ sa) << 4));
#pragma unroll
  for (int mi = 0; mi < MI; ++mi) fb[0][mi] = *(const bf16x8*)(Ab + (rowb0 + 32 * mi) * 128 + ((hi ^ sb) << 4));
#pragma unroll
  for (int k16 = 0; k16 < 4; ++k16) {
    if (k16 < 3) {
      const int chn = (k16 + 1) * 2 + hi;
#pragma unroll
      for (int ni = 0; ni < 2 * NC; ++ni) fa[(k16 + 1) & 1][ni] = *(const bf16x8*)(Bb + (rowa0 + 32 * ni) * 128 + ((chn ^ sa) << 4));
#pragma unroll
      for (int mi = 0; mi < MI; ++mi) fb[(k16 + 1) & 1][mi] = *(const bf16x8*)(Ab + (rowb0 + 32 * mi) * 128 + ((chn ^ sb) << 4));
    }
    SBAR();
#pragma unroll
    for (int ni = 0; ni < 2 * NC; ++ni)
#pragma unroll
      for (int mi = 0; mi < MI; ++mi)
        acc[ni][mi] = __builtin_amdgcn_mfma_f32_32x32x16_bf16(fa[k16 & 1][ni], fb[k16 & 1][mi], acc[ni][mi], 0, 0, 0);
    SBAR();
  }
}

template <int MI, int NC>
DEVI void gemm_kloop(f32x16 (&acc)[2 * NC][MI], const u16* __restrict__ A, long lda, const u16* __restrict__ Bt, long ldb, int K, char* lds) {
  const int tid = otid(), wid = tid >> 6, lane = tid & 63, r32 = lane & 31, hi = lane >> 5;
  const int wm = wid & 3, wn = wid >> 2;
  constexpr int ABUF = 32768, BBUF = 16384 * NC;
  char* As = lds; char* Bs = lds + 65536;
  const int ch = tid & 7, rw = tid >> 3;
  const int swz = ((ch ^ ((rw >> 1) & 7)) << 4);
  u32x4 ra[2 * MI], rb[2 * NC];
  const u16* Ap = A + (long)rw * lda + ch * 8;
  const u16* Bp = Bt + (long)rw * ldb + ch * 8;
#define GLOAD(k0) do { _Pragma("unroll") for (int i_ = 0; i_ < 2 * MI; ++i_) ra[i_] = *(const u32x4*)(Ap + (long)(64 * i_) * lda + (k0)); \
    _Pragma("unroll") for (int i_ = 0; i_ < 2 * NC; ++i_) rb[i_] = *(const u32x4*)(Bp + (long)(64 * i_) * ldb + (k0)); } while (0)
#define GWRITE(buf) do { char* a_ = As + (buf) * ABUF + rw * 128 + swz; char* b_ = Bs + (buf) * BBUF + rw * 128 + swz; \
    _Pragma("unroll") for (int i_ = 0; i_ < 2 * MI; ++i_) *(u32x4*)(a_ + i_ * 64 * 128) = ra[i_]; \
    _Pragma("unroll") for (int i_ = 0; i_ < 2 * NC; ++i_) *(u32x4*)(b_ + i_ * 64 * 128) = rb[i_]; } while (0)
#pragma unroll
  for (int i = 0; i < 2 * NC; ++i)
#pragma unroll
    for (int j = 0; j < MI; ++j)
#pragma unroll
      for (int r = 0; r < 16; ++r) acc[i][j][r] = 0.f;
  const int KT = K >> 6;
  const int grp = __builtin_amdgcn_readfirstlane(wid) >> 2;
  const int rowa0 = wn * (64 * NC) + r32, rowb0 = wm * (32 * MI) + r32;
  const int sa = (rowa0 >> 1) & 7, sb = (rowb0 >> 1) & 7;
#define MFMA_ALL(kt_) mfma_tile<MI, NC>(acc, As + ((kt_) & 1) * ABUF, Bs + ((kt_) & 1) * BBUF, rowa0, rowb0, sa, sb, hi)
#define KBAR() do { asm volatile("s_waitcnt lgkmcnt(0)" ::: "memory"); __builtin_amdgcn_s_barrier(); asm volatile("" ::: "memory"); } while (0)
  GLOAD(0); GWRITE(0); SBAR();
  if (KT > 1) GLOAD(64);
  KBAR();
  if (grp == 0) {
    for (int kt = 0; kt < KT; ++kt) {
      MFMA_ALL(kt);
      KBAR();
      if (kt + 1 < KT) { GWRITE((kt + 1) & 1); if (kt + 2 < KT) GLOAD((kt + 2) * 64); }
      KBAR();
    }
  } else {
    for (int kt = 0; kt < KT; ++kt) {
      if (kt + 1 < KT) { GWRITE((kt + 1) & 1); if (kt + 2 < KT) GLOAD((kt + 2) * 64); }
      KBAR();
      MFMA_ALL(kt);
      KBAR();
    }
  }
#undef KBAR
#undef MFMA_ALL
#undef GLOAD
#undef GWRITE
}

DEVI int map_col(int mode, int n) {
  if (mode == 0) return n;
  if (mode == 1) {
    if (n < 3072) return n;
    if (n < 6528) return n + 32;
    if (n < 9600) return n + 96;
    if (n < 9664) return 6560 + (n - 9600);
    if (n < 9696) return 3072 + (n - 9664);
    return -1;
  }
  const int grp = n >> 6, w = n & 63;
  return (w < 32) ? (grp * 32 + w) : (FH + grp * 32 + (w - 32));
}
DEVI void conv_weight(const float* __restrict__ src, int ldsrc, u16* __restrict__ dst, int Ndst, int K, int mode, const float* __restrict__ kscale, char* lds) {
  float* t = (float*)lds;
  const int tid = otid();
  const int ntn = Ndst >> 6, ntk = K >> 6;
  for (int tile = blockIdx.x; tile < ntn * ntk; tile += gridDim.x) {
    const int n0 = (tile / ntk) << 6, k0 = (tile % ntk) << 6;
    __syncthreads();
#pragma unroll
    for (int it = 0; it < 2; ++it) {
      const int idx = tid + it * NTHREADS, kk = idx >> 4, n4 = (idx & 15) * 4;
      const int sc = map_col(mode, n0 + n4);
      f32x4 v = {0.f, 0.f, 0.f, 0.f};
      if (sc >= 0) v = *(const f32x4*)(src + (long)(k0 + kk) * ldsrc + sc);
      if (kscale) { const float ks = kscale[k0 + kk]; v[0] *= ks; v[1] *= ks; v[2] *= ks; v[3] *= ks; }
      t[(n4 + 0) * 68 + kk] = v[0]; t[(n4 + 1) * 68 + kk] = v[1]; t[(n4 + 2) * 68 + kk] = v[2]; t[(n4 + 3) * 68 + kk] = v[3];
    }
    __syncthreads();
    {
      const int nn = tid >> 3, k8 = (tid & 7) * 8;
      const f32x4 a = *(const f32x4*)(t + nn * 68 + k8), c = *(const f32x4*)(t + nn * 68 + k8 + 4);
      u32x4 w = {cvtpk(a[0], a[1]), cvtpk(a[2], a[3]), cvtpk(c[0], c[1]), cvtpk(c[2], c[3])};
      *(u32x4*)(dst + (long)(n0 + nn) * K + k0 + k8) = w;
    }
  }
  __syncthreads();
}

DEVI void phase_modv(const Params& p, char* lds) {
  float* ca = (float*)lds;
  float* red = ca + 9 * 1024;
  float* modv = (float*)(p.ws + OFF_MODV);
  const int tid = otid();
  __syncthreads();
  for (int i = tid; i < 9 * 1024; i += NTHREADS) {
    const float v = (i < 8192) ? p.c[i] : p.c_ctx[i - 8192];
    ca[i] = siluf(v);
  }
  __syncthreads();
  const int col = tid & 63, ks = tid >> 6;
  for (int tile = blockIdx.x; tile < 2 * 96; tile += gridDim.x) {
    const int l = tile / 96, n0 = (tile % 96) * 64;
    const float* W = p.w_mod + (long)l * 1024 * 6144 + n0 + col;
    float a[9];
#pragma unroll
    for (int j = 0; j < 9; ++j) a[j] = 0.f;
    for (int k = ks * 128; k < ks * 128 + 128; ++k) {
      const float w = W[(long)k * 6144];
#pragma unroll
      for (int j = 0; j < 9; ++j) a[j] += ca[j * 1024 + k] * w;
    }
#pragma unroll
    for (int j = 0; j < 9; ++j) red[(ks * 64 + col) * 9 + j] = a[j];
    __syncthreads();
    for (int i = tid; i < 64 * 9; i += NTHREADS) {
      const int cc = i / 9, j = i % 9;
      float s = 0.f;
      for (int q = 0; q < 8; ++q) s += red[(q * 64 + cc) * 9 + j];
      modv[((long)l * 9 + j) * 6144 + n0 + cc] = s + p.b_mod[l * 6144 + n0 + cc];
    }
    __syncthreads();
  }
}

DEVI void phase_rope(const Params& p) {
  float* rope = (float*)(p.ws + OFF_ROPE);
  for (int i = blockIdx.x * NTHREADS + otid(); i < SEQ * 32; i += gridDim.x * NTHREADS) {
    const int t = i >> 5, f = i & 31;
    const float inv = powf(10000.f, -(float)(f & 15) / 16.f);
    const float pos = (f < 16) ? (float)(t >> 6) : (float)(t & 63);
    const float ang = pos * inv;
    rope[t * 64 + f] = cosf(ang);
    rope[t * 64 + 32 + f] = sinf(ang);
  }
}

DEVI void ln_stats(const float (&v)[16], float& mu, float& rstd) {
  float s = 0.f;
#pragma unroll
  for (int i = 0; i < 16; ++i) s += v[i];
  mu = wave_sum(s) * (1.f / 1024.f);
  float q = 0.f;
#pragma unroll
  for (int i = 0; i < 16; ++i) { const float d = v[i] - mu; q += d * d; }
  rstd = rsqrtf(wave_sum(q) * (1.f / 1024.f) + EPS);
}
DEVI void rowload(const float* __restrict__ src, float (&v)[16]) {
  const int lane = otid() & 63;
#pragma unroll
  for (int i = 0; i < 4; ++i) {
    const f32x4 t = *(const f32x4*)(src + i * 256 + lane * 4);
    v[i * 4 + 0] = t[0]; v[i * 4 + 1] = t[1]; v[i * 4 + 2] = t[2]; v[i * 4 + 3] = t[3];
  }
}
DEVI void rowproc(float (&v)[16], float* __restrict__ dst, const float* __restrict__ ag, const float* __restrict__ ab,
                  u16* __restrict__ hout, const float* __restrict__ sh, const float* __restrict__ sc) {
  const int lane = otid() & 63;
  float mu, rstd;
  if (ag) {
    ln_stats(v, mu, rstd);
#pragma unroll
    for (int i = 0; i < 4; ++i) {
      const f32x4 g = *(const f32x4*)(ag + i * 256 + lane * 4);
      const f32x4 b = *(const f32x4*)(ab + i * 256 + lane * 4);
      f32x4 o;
#pragma unroll
      for (int j = 0; j < 4; ++j) { v[i * 4 + j] = (v[i * 4 + j] - mu) * rstd * g[j] + b[j]; o[j] = v[i * 4 + j]; }
      *(f32x4*)(dst + i * 256 + lane * 4) = o;
    }
  }
  if (hout) {
    ln_stats(v, mu, rstd);
#pragma unroll
    for (int i = 0; i < 4; ++i) {
      const f32x4 s1 = *(const f32x4*)(sc + i * 256 + lane * 4);
      const f32x4 s0 = *(const f32x4*)(sh + i * 256 + lane * 4);
      float h[4];
#pragma unroll
      for (int j = 0; j < 4; ++j) h[j] = (v[i * 4 + j] - mu) * rstd * (1.f + s1[j]) + s0[j];
      st4bf(hout + i * 256 + lane * 4, h[0], h[1], h[2], h[3]);
    }
  }
}
DEVI int rr_of(int r) { return r >= ROWS ? r - ROWS : r; }
DEVI int bi_of(int r) { return r >= ROWS ? 1 : 0; }
DEVI const float* modvec(const Params& p, int l, int ps, int r, int which) {
  const float* modv = (const float*)(p.ws + OFF_MODV);
  const int j = (rr_of(r) < SEQ) ? (ps * NBP + bi_of(r)) : 8;
  return modv + ((long)l * 9 + j) * 6144 + which * 1024;
}
DEVI const float* inrow(const Params& p, int ps, int r) {
  const int b = ps * NBP + bi_of(r), rr = rr_of(r);
  return (rr < SEQ) ? (p.x + ((long)b * SEQ + rr) * 1024) : (p.ctx + ((long)b * CTXL + (rr - SEQ)) * 1024);
}
DEVI float* xrow(const Params& p, int ps, int r) {
  const int b = ps * NBP + bi_of(r), rr = rr_of(r);
  return (rr < SEQ) ? (p.out + ((long)b * SEQ + rr) * 1024) : ((float*)(p.ws + OFF_XC) + (long)(bi_of(r) * CTXL + rr - SEQ) * 1024);
}
DEVI int row_next(int r, int nw, bool skipctx) { while (r < RP && skipctx && rr_of(r) >= SEQ) r += nw; return r; }
DEVI void row_loop(const Params& p, int ps, int l, int kind) {
  const int gw = blockIdx.x * 8 + (otid() >> 6), nw = gridDim.x * 8;
  const bool skipctx = (kind == 1 && l == 1) || kind == 3;
  u16* Hb = (u16*)(p.ws + OFF_H);
  float v[16], vn[16];
  int r = row_next(gw, nw, skipctx);
  if (r < RP) rowload(kind == 0 ? inrow(p, ps, r) : xrow(p, ps, r), v);
  while (r < RP) {
    const int rn = row_next(r + nw, nw, skipctx);
    if (rn < RP) rowload(kind == 0 ? inrow(p, ps, rn) : xrow(p, ps, rn), vn);
    float* xr = xrow(p, ps, r);
    u16* hrow = Hb + (long)r * 1024;
    if (kind == 0)      rowproc(v, nullptr, nullptr, nullptr, hrow, modvec(p, 0, ps, r, 0), modvec(p, 0, ps, r, 1));
    else if (kind == 1) rowproc(v, xr, p.ln1_g + l * 1024, p.ln1_b + l * 1024, hrow, modvec(p, l, ps, r, 3), modvec(p, l, ps, r, 4));
    else if (kind == 2) rowproc(v, xr, p.ln2_g, p.ln2_b, hrow, modvec(p, 1, ps, r, 0), modvec(p, 1, ps, r, 1));
    else                rowproc(v, xr, p.ln2_g + 1024, p.ln2_b + 1024, nullptr, nullptr, nullptr);
#pragma unroll
    for (int i = 0; i < 16; ++i) v[i] = vn[i];
    r = rn;
  }
}
DEVI void phase_mod1_l0(const Params& p, int ps) { row_loop(p, ps, 0, 0); }
DEVI void phase_rows_a(const Params& p, int ps, int l) { row_loop(p, ps, l, 1); }
DEVI void phase_rows_b(const Params& p, int ps, int l) {
  if (l == 0) row_loop(p, ps, 0, 2);
  else { row_loop(p, ps, 1, 3); if (ps + 1 < NPASS) row_loop(p, ps + 1, 0, 0); }
}
DEVI int tile_m0(int tm, int l, int TR) { const int tpb = (l == 0 ? ROWS : SEQ) / TR; return (tm / tpb) * ROWS + (tm % tpb) * TR; }
DEVI int tile_ntm(int l, int TR) { return NBP * ((l == 0 ? ROWS : SEQ) / TR); }

template <int NCOLS> DEVI void wave_tile_store(const char* wl, u16* gbase, long ld, int lane) {
  constexpr int RS = NCOLS * 2 + 16, CPR = NCOLS / 8, RPI = 64 / CPR;
  const int rsub = lane / CPR, chk = lane % CPR;
  SBAR();
#pragma unroll 4
  for (int it = 0; it < 64 / RPI; ++it) {
    const int row = it * RPI + rsub;
    const u32x4 v = *(const u32x4*)(wl + row * RS + chk * 16);
    *(u32x4*)(gbase + (long)row * ld + chk * 8) = v;
  }
}
DEVI void lds_put4(char* wl, int RS, int row, int col, float a, float b, float c, float d) { u32x2 w = {cvtpk(a, b), cvtpk(c, d)}; *(u32x2*)(wl + row * RS + col * 2) = w; }

DEVI void phase_gemm_in(const Params& p, int l, char* lds) {
  const u16* H = (const u16*)(p.ws + OFF_H);
  const u16* W = (const u16*)(p.ws + OFF_WIN) + (long)l * NF * 1024;
  u16* feat = (u16*)(p.ws + OFF_FEAT);
  const float* rope = (const float*)(p.ws + OFF_ROPE);
  const int lane = otid() & 63, wid = otid() >> 6, r32 = lane & 31, hi = lane >> 5, wm = wid & 3, wn = wid >> 2;
  constexpr int NTN = NF / 256, NTM = RP / 256;
  for (int tile = vblock(); tile < NTN * NTM; tile += gridDim.x) {
    int tm, tn; tile_map(tile, NTM, NTN, tm, tn);
    const int m0 = tm * 256, n0 = tn * 256;
    f32x16 acc[4][2];
    __syncthreads();
    gemm_kloop<2, 2>(acc, H + (long)m0 * 1024, 1024, W + (long)n0 * 1024, 1024, 1024, lds);
    SBAR();
    char* wl = lds + wid * (64 * 272);
#pragma unroll
    for (int cg2 = 0; cg2 < 2; ++cg2) {
      SBAR();
      const int cb = n0 + wn * 128 + cg2 * 64;
      int mode = 0;
      if (cb < F_GK) mode = 1;
      else if ((cb >= F_DQ && cb < F_DV) || cb == F_KR) mode = 2;
      else if (cb >= F_GATE && cb < F_KR) mode = 3;
#pragma unroll
      for (int mi = 0; mi < 2; ++mi) {
        const int m = m0 + wm * 64 + mi * 32 + r32;
#pragma unroll
        for (int q = 0; q < 4; ++q) {
          const int ci = q * 8 + hi * 4;
          float x1[4], x2[4];
#pragma unroll
          for (int j = 0; j < 4; ++j) { x1[j] = acc[2 * cg2][mi][q * 4 + j]; x2[j] = acc[2 * cg2 + 1][mi][q * 4 + j]; }
          if (mode == 1) {
#pragma unroll
            for (int j = 0; j < 4; ++j) { x1[j] *= 0.08838834764831845f; x2[j] *= 0.08838834764831845f; }
          } else if (mode == 2) {
            if (rr_of(m) < SEQ) {
              const f32x4 cs = *(const f32x4*)(rope + (long)rr_of(m) * 64 + ci);
              const f32x4 sn = *(const f32x4*)(rope + (long)rr_of(m) * 64 + 32 + ci);
#pragma unroll
              for (int j = 0; j < 4; ++j) { const float a = x1[j], bb = x2[j]; x1[j] = a * cs[j] - bb * sn[j]; x2[j] = a * sn[j] + bb * cs[j]; }
            }
          } else if (mode == 3) {
#pragma unroll
            for (int j = 0; j < 4; ++j) { x1[j] = sigmf(x1[j]); x2[j] = sigmf(x2[j]); }
          }
          lds_put4(wl, 272, mi * 32 + r32, cg2 * 64 + ci, x1[0], x1[1], x1[2], x1[3]);
          lds_put4(wl, 272, mi * 32 + r32, cg2 * 64 + 32 + ci, x2[0], x2[1], x2[2], x2[3]);
        }
      }
    }
    wave_tile_store<128>(wl, feat + (long)(m0 + wm * 64) * NF + n0 + wn * 128, NF, lane);
  }
}

DEVI void phase_gemm_up(const Params& p, int l, char* lds) {
  const u16* feat = (const u16*)(p.ws + OFF_FEAT);
  const float* rope = (const float*)(p.ws + OFF_ROPE);
  float* rs = (float*)(lds + 98304);
  const int tid = otid(), lane = tid & 63, wid = tid >> 6, r32 = lane & 31, hi = lane >> 5, wm = wid & 3, wn = wid >> 2;
  constexpr int NTM = RP / 256, NQ = 12, NK = 16;
  for (int tile = vblock(); tile < NTM * (NQ + NK); tile += gridDim.x) {
    int tm, tn; tile_map(tile, NTM, NQ + NK, tm, tn);
    const bool isq = tn < NQ;
    const int m0 = tm * 256, n0 = (isq ? tn : tn - NQ) * 128;
    const int K = isq ? 256 : 128;
    const u16* A = feat + (long)m0 * NF + (isq ? F_MQ : F_MKV);
    const u16* W = isq ? ((const u16*)(p.ws + OFF_WUQ) + (long)l * 1536 * 256 + (long)n0 * 256)
                       : ((const u16*)(p.ws + OFF_WUKV) + (long)l * 2048 * 128 + (long)n0 * 128);
    __syncthreads();
    {
      const int row = tid >> 1, half = tid & 1, n8 = K / 16;
      const u16* ap = A + (long)row * NF + half * (K / 2);
      float ss = 0.f;
      for (int i = 0; i < n8; ++i) {
        const u32x4 w = *(const u32x4*)(ap + i * 8);
#pragma unroll
        for (int j = 0; j < 4; ++j) { const float a = bflo(w[j]), b = bfhi(w[j]); ss += a * a + b * b; }
      }
      ss += __shfl_xor(ss, 1);
      if (half == 0) rs[row] = rsqrtf(ss / (float)K + EPS);
    }
    f32x16 acc[2][2];
    gemm_kloop<2, 1>(acc, A, NF, W, K, K, lds);
    const int cb = n0 + wn * 64;
    const bool dorope = isq && ((cb % 192) == 128);
    u16* outp = isq ? (u16*)(p.ws + OFF_QM) : (u16*)(p.ws + OFF_KV);
    const int ldo = isq ? 1536 : 2048;
    char* wl = lds + wid * (64 * 144);
#pragma unroll
    for (int mi = 0; mi < 2; ++mi) {
      const int ml = wm * 64 + mi * 32 + r32, m = m0 + ml;
      const float sc = rs[ml];
#pragma unroll
      for (int q = 0; q < 4; ++q) {
        const int ci = q * 8 + hi * 4;
        float x1[4], x2[4];
#pragma unroll
        for (int j = 0; j < 4; ++j) { x1[j] = acc[0][mi][q * 4 + j] * sc; x2[j] = acc[1][mi][q * 4 + j] * sc; }
        if (dorope && rr_of(m) < SEQ) {
          const f32x4 cs = *(const f32x4*)(rope + (long)rr_of(m) * 64 + ci);
          const f32x4 sn = *(const f32x4*)(rope + (long)rr_of(m) * 64 + 32 + ci);
#pragma unroll
          for (int j = 0; j < 4; ++j) { const float a = x1[j], bb = x2[j]; x1[j] = a * cs[j] - bb * sn[j]; x2[j] = a * sn[j] + bb * cs[j]; }
        }
        lds_put4(wl, 144, mi * 32 + r32, ci, x1[0], x1[1], x1[2], x1[3]);
        lds_put4(wl, 144, mi * 32 + r32, 32 + ci, x2[0], x2[1], x2[2], x2[3]);
      }
    }
    wave_tile_store<64>(wl, outp + (long)(m0 + wm * 64) * ldo + cb, ldo, lane);
  }
}

DEVI void phase_gemm_br(const Params& p, int l, char* lds) {
  const u16* feat = (const u16*)(p.ws + OFF_FEAT);
  u16* Y = (u16*)(p.ws + OFF_Y);
  const int lane = otid() & 63, wid = otid() >> 6, r32 = lane & 31, hi = lane >> 5, wm = wid & 3, wn = wid >> 2;
  const int NTM = tile_ntm(l, 128);
  for (int tile = vblock(); tile < NTM * 8; tile += gridDim.x) {
    int tm, tn; tile_map(tile, NTM, 8, tm, tn);
    const int m0 = tile_m0(tm, l, 128), n0 = tn * 128;
    const int m = m0 + wm * 32 + r32;
    f32x16 tot[2];
#pragma unroll
    for (int i = 0; i < 3; ++i) {
      const u16* A = (const u16*)(p.ws + (i == 0 ? OFF_YA : (i == 1 ? OFF_YB : OFF_YC))) + (long)m0 * 1024;
      const u16* W = (const u16*)(p.ws + OFF_WBR) + ((long)(l * 3 + i) * 1024 + n0) * 1024;
      f32x16 acc[2][1];
      gemm_kloop<1, 1>(acc, A, 1024, W, 1024, 1024, lds);
#pragma unroll
      for (int ni = 0; ni < 2; ++ni)
#pragma unroll
        for (int q = 0; q < 4; ++q) {
          const int n = n0 + wn * 64 + ni * 32 + q * 8 + hi * 4;
          const u32x2 g = *(const u32x2*)(feat + (long)m * NF + F_GATE + i * 1024 + n);
          const float g0 = bflo(g[0]), g1 = bfhi(g[0]), g2 = bflo(g[1]), g3 = bfhi(g[1]);
          if (i == 0) {
            tot[ni][q * 4 + 0] = g0 * acc[ni][0][q * 4 + 0]; tot[ni][q * 4 + 1] = g1 * acc[ni][0][q * 4 + 1];
            tot[ni][q * 4 + 2] = g2 * acc[ni][0][q * 4 + 2]; tot[ni][q * 4 + 3] = g3 * acc[ni][0][q * 4 + 3];
          } else {
            tot[ni][q * 4 + 0] += g0 * acc[ni][0][q * 4 + 0]; tot[ni][q * 4 + 1] += g1 * acc[ni][0][q * 4 + 1];
            tot[ni][q * 4 + 2] += g2 * acc[ni][0][q * 4 + 2]; tot[ni][q * 4 + 3] += g3 * acc[ni][0][q * 4 + 3];
          }
        }
    }
#pragma unroll
    for (int ni = 0; ni < 2; ++ni)
#pragma unroll
      for (int q = 0; q < 4; ++q) {
        const int n = n0 + wn * 64 + ni * 32 + q * 8 + hi * 4;
        st4bf(Y + (long)m * 1024 + n, tot[ni][q * 4 + 0], tot[ni][q * 4 + 1], tot[ni][q * 4 + 2], tot[ni][q * 4 + 3]);
      }
  }
}

DEVI void phase_gemm_res(const Params& p, int ps, int l, int which, char* lds) {
  const int lane = otid() & 63, wid = otid() >> 6, r32 = lane & 31, hi = lane >> 5, wm = wid & 3, wn = wid >> 2;
  const int NTM = tile_ntm(l, 128);
  const bool first = (which == 2);
  const int K = first ? 1024 : FH;
  const u16* Abase = first ? (const u16*)(p.ws + OFF_Y) : (const u16*)(p.ws + OFF_HID);
  const u16* Wbase = first ? ((const u16*)(p.ws + OFF_WOUT) + (long)l * 1024 * 1024) : ((const u16*)(p.ws + OFF_WF2) + (long)l * 1024 * FH);
  for (int tile = vblock(); tile < NTM * 8; tile += gridDim.x) {
    int tm, tn; tile_map(tile, NTM, 8, tm, tn);
    const int m0 = tile_m0(tm, l, 128), n0 = tn * 128;
    const int m = m0 + wm * 32 + r32;
    const float* gv = modvec(p, l, ps, m, which);
    float* dst = xrow(p, ps, m);
    const float* xin = dst;
    if (first && l == 0) xin = inrow(p, ps, m);
    f32x4 xi[8], g[8];
#pragma unroll
    for (int ni = 0; ni < 2; ++ni)
#pragma unroll
      for (int q = 0; q < 4; ++q) {
        const int n = n0 + wn * 64 + ni * 32 + q * 8 + hi * 4;
        xi[ni * 4 + q] = *(const f32x4*)(xin + n);
        g[ni * 4 + q] = *(const f32x4*)(gv + n);
      }
    SBAR();
    f32x16 acc[2][1];
    gemm_kloop<1, 1>(acc, Abase + (long)m0 * K, K, Wbase + (long)n0 * K, K, K, lds);
    SBAR();
#pragma unroll
    for (int ni = 0; ni < 2; ++ni)
#pragma unroll
      for (int q = 0; q < 4; ++q) {
        const int n = n0 + wn * 64 + ni * 32 + q * 8 + hi * 4;
        f32x4 o;
#pragma unroll
        for (int j = 0; j < 4; ++j) o[j] = ALPHA * xi[ni * 4 + q][j] + g[ni * 4 + q][j] * acc[ni][0][q * 4 + j];
        *(f32x4*)(dst + n) = o;
      }
  }
}

DEVI void phase_gemm_f1(const Params& p, int l, char* lds) {
  const u16* H = (const u16*)(p.ws + OFF_H);
  const u16* W = (const u16*)(p.ws + OFF_WF1) + (long)l * 5632 * 1024;
  u16* hid = (u16*)(p.ws + OFF_HID);
  const int lane = otid() & 63, wid = otid() >> 6, r32 = lane & 31, hi = lane >> 5, wm = wid & 3, wn = wid >> 2;
  const int NTM = tile_ntm(l, 256);
  for (int tile = vblock(); tile < NTM * 22; tile += gridDim.x) {
    int tm, tn; tile_map(tile, NTM, 22, tm, tn);
    const int m0 = tile_m0(tm, l, 256), n0 = tn * 256;
    f32x16 acc[4][2];
    __syncthreads();
    gemm_kloop<2, 2>(acc, H + (long)m0 * 1024, 1024, W + (long)n0 * 1024, 1024, 1024, lds);
    char* wl = lds + wid * (64 * 144);
#pragma unroll
    for (int cg2 = 0; cg2 < 2; ++cg2) {
#pragma unroll
      for (int mi = 0; mi < 2; ++mi) {
#pragma unroll
        for (int q = 0; q < 4; ++q) {
          float h[4];
#pragma unroll
          for (int j = 0; j < 4; ++j) h[j] = siluf(acc[2 * cg2][mi][q * 4 + j]) * acc[2 * cg2 + 1][mi][q * 4 + j];
          lds_put4(wl, 144, mi * 32 + r32, cg2 * 32 + q * 8 + hi * 4, h[0], h[1], h[2], h[3]);
        }
      }
    }
    wave_tile_store<64>(wl, hid + (long)(m0 + wm * 64) * FH + (tn * 4 + wn * 2) * 32, FH, lane);
  }
}

DEVI void phase_prep(const Params& p, int l) {
  const int lane = otid() & 63;
  const int gw = blockIdx.x * 8 + (otid() >> 6), nw = gridDim.x * 8;
  const float lam_init = 0.8f - 0.6f * expf(-0.3f * (float)l);
  const float* dl = p.diff_lam + l * 256;
  const float s01 = wave_sum(dl[lane] * dl[64 + lane]), s23 = wave_sum(dl[128 + lane] * dl[192 + lane]);
  const float lam = expf(s01) - expf(s23) + lam_init;
  const u16* feat = (const u16*)(p.ws + OFF_FEAT);
  const u16* og0 = (const u16*)(p.ws + OFF_OG); const u16* og1 = og0 + (long)RP * 1024;
  const u16* od0 = (const u16*)(p.ws + OFF_OD); const u16* od1 = od0 + (long)RP * 1024;
  u16* ya = (u16*)(p.ws + OFF_YA); u16* yb = (u16*)(p.ws + OFF_YB);
  const f32x4 gg = *(const f32x4*)(p.gla_norm_g + l * 256 + lane * 4);
  const float dg0 = p.diff_norm_g[l * 128 + lane * 2] * (1.f - lam_init), dg1 = p.diff_norm_g[l * 128 + lane * 2 + 1] * (1.f - lam_init);
  for (int r = gw; r < RP; r += nw) {
    if (l == 1 && rr_of(r) >= SEQ) continue;
    u32x2 ga[4], gb[4], gr[4]; unsigned da[8], db[8];
#pragma unroll
    for (int u = 0; u < 4; ++u) {
      const long off = (long)r * 1024 + u * 256 + lane * 4;
      ga[u] = *(const u32x2*)(og0 + off); gb[u] = *(const u32x2*)(og1 + off);
      gr[u] = *(const u32x2*)(feat + (long)r * NF + F_GR + u * 256 + lane * 4);
    }
#pragma unroll
    for (int h = 0; h < 8; ++h) {
      const long off = (long)r * 1024 + h * 128 + lane * 2;
      da[h] = *(const unsigned*)(od0 + off); db[h] = *(const unsigned*)(od1 + off);
    }
    float o[4][4], ss[4], e0[8], e1[8], sd[8];
#pragma unroll
    for (int u = 0; u < 4; ++u) {
      o[u][0] = bflo(ga[u][0]) + bflo(gb[u][0]); o[u][1] = bfhi(ga[u][0]) + bfhi(gb[u][0]);
      o[u][2] = bflo(ga[u][1]) + bflo(gb[u][1]); o[u][3] = bfhi(ga[u][1]) + bfhi(gb[u][1]);
      ss[u] = o[u][0] * o[u][0] + o[u][1] * o[u][1] + o[u][2] * o[u][2] + o[u][3] * o[u][3];
    }
#pragma unroll
    for (int h = 0; h < 8; ++h) {
      e0[h] = bflo(da[h]) - lam * bflo(db[h]); e1[h] = bfhi(da[h]) - lam * bfhi(db[h]);
      sd[h] = e0[h] * e0[h] + e1[h] * e1[h];
    }
#pragma unroll
    for (int m = 32; m >= 1; m >>= 1) {
#pragma unroll
      for (int u = 0; u < 4; ++u) ss[u] += __shfl_xor(ss[u], m);
#pragma unroll
      for (int h = 0; h < 8; ++h) sd[h] += __shfl_xor(sd[h], m);
    }
#pragma unroll
    for (int u = 0; u < 4; ++u) {
      const float rsd = rsqrtf(ss[u] * (1.f / 256.f) + EPS);
      const float rv[4] = {bflo(gr[u][0]), bfhi(gr[u][0]), bflo(gr[u][1]), bfhi(gr[u][1])};
      float y[4];
#pragma unroll
      for (int j = 0; j < 4; ++j) y[j] = o[u][j] * rsd * gg[j] * siluf(rv[j]);
      st4bf(ya + (long)r * 1024 + u * 256 + lane * 4, y[0], y[1], y[2], y[3]);
    }
#pragma unroll
    for (int h = 0; h < 8; ++h) {
      const float rsd = rsqrtf(sd[h] * (1.f / 128.f) + EPS);
      *(unsigned*)(yb + (long)r * 1024 + h * 128 + lane * 2) = cvtpk(e0[h] * rsd * dg0, e1[h] * rsd * dg1);
    }
  }
}

DEVI int v_st(int k, int c) { const int kk = (k & ~0xC) | ((k & 4) << 1) | ((k & 8) >> 1); return ((kk >> 3) * 4 + (c >> 5)) * 512 + ((kk & 7) * 32 + (c & 31)) * 2; }
DEVI int v_rd_base(int lane) { return ((lane & 3) << 3) | (((lane >> 2) & 3) << 6) | (((lane >> 4) & 1) << 5) | (((lane >> 5) & 1) << 8); }
constexpr int v_rd_off(int d0, int ks, int half) { return d0 * 512 + ks * 4096 + half * 2048; }
template <int OFF> DEVI s16x4 tr_read(int vb) {
  s16x4 r; asm volatile("ds_read_b64_tr_b16 %0, %1 offset:%2" : "=&v"(r) : "v"(vb), "i"(OFF) : "memory"); return r;
}
template <int D0> DEVI void pv_one(f32x16& od, int vb, bf16x8 pa0, bf16x8 pa1, bf16x8 pa2, bf16x8 pa3) {
  const s16x4 l0 = tr_read<v_rd_off(D0, 0, 0)>(vb), h0 = tr_read<v_rd_off(D0, 0, 1)>(vb), l1 = tr_read<v_rd_off(D0, 1, 0)>(vb), h1 = tr_read<v_rd_off(D0, 1, 1)>(vb);
  const s16x4 l2 = tr_read<v_rd_off(D0, 2, 0)>(vb), h2 = tr_read<v_rd_off(D0, 2, 1)>(vb), l3 = tr_read<v_rd_off(D0, 3, 0)>(vb), h3 = tr_read<v_rd_off(D0, 3, 1)>(vb);
  asm volatile("s_waitcnt lgkmcnt(0)" ::: "memory"); SBAR();
#define PK(L, H) (bf16x8){L[0], L[1], L[2], L[3], H[0], H[1], H[2], H[3]}
  od = __builtin_amdgcn_mfma_f32_32x32x16_bf16(pa0, PK(l0, h0), od, 0, 0, 0);
  od = __builtin_amdgcn_mfma_f32_32x32x16_bf16(pa1, PK(l1, h1), od, 0, 0, 0);
  od = __builtin_amdgcn_mfma_f32_32x32x16_bf16(pa2, PK(l2, h2), od, 0, 0, 0);
  od = __builtin_amdgcn_mfma_f32_32x32x16_bf16(pa3, PK(l3, h3), od, 0, 0, 0);
#undef PK
}
DEVI void pv_d0(f32x16* o, int vb, bf16x8 pa0, bf16x8 pa1, bf16x8 pa2, bf16x8 pa3) {
  pv_one<0>(o[0], vb, pa0, pa1, pa2, pa3); pv_one<1>(o[1], vb, pa0, pa1, pa2, pa3); pv_one<2>(o[2], vb, pa0, pa1, pa2, pa3); pv_one<3>(o[3], vb, pa0, pa1, pa2, pa3);
}
constexpr float ATT_THR = 8.f;
DEVI void partialSM(f32x16& p0, f32x16& p1, float& m_reg, float& mn, float& alpha, float scale) {
  const float C = scale * 1.4426950408889634f;
  float pmax = p0[0];
#pragma unroll
  for (int r = 1; r < 16; ++r) pmax = fmaxf(pmax, p0[r]);
#pragma unroll
  for (int r = 0; r < 16; ++r) pmax = fmaxf(pmax, p1[r]);
  { auto rr = __builtin_amdgcn_permlane32_swap(__float_as_uint(pmax), __float_as_uint(pmax), false, false);
    pmax = fmaxf(__uint_as_float(rr[0]), __uint_as_float(rr[1])); }
  if (__builtin_expect(__all(pmax - m_reg <= ATT_THR / scale), 1)) { mn = m_reg; alpha = 1.f; }
  else { mn = fmaxf(m_reg, pmax); alpha = __builtin_amdgcn_exp2f((m_reg - mn) * C); m_reg = mn; }
  const float mnC = -mn * C;
#pragma unroll
  for (int r = 0; r < 16; ++r) p0[r] = fmaf(p0[r], C, mnC);
#pragma unroll
  for (int r = 0; r < 16; ++r) p1[r] = fmaf(p1[r], C, mnC);
#pragma unroll
  for (int r = 0; r < 16; ++r) p0[r] = __builtin_amdgcn_exp2f(p0[r]);
}
#define PK4(P, BASE, OUT) do { unsigned a0 = cvtpk(P[BASE + 0], P[BASE + 1]), a1 = cvtpk(P[BASE + 2], P[BASE + 3]);   \
    unsigned b0 = cvtpk(P[BASE + 4], P[BASE + 5]), b1 = cvtpk(P[BASE + 6], P[BASE + 7]);                              \
    auto r0 = __builtin_amdgcn_permlane32_swap(a0, b0, false, false); auto r1 = __builtin_amdgcn_permlane32_swap(a1, b1, false, false); \
    u32x4 w = {r0[0], r1[0], r0[1], r1[1]}; OUT = *reinterpret_cast<bf16x8*>(&w); } while (0)
DEVI void finishSM(f32x16& p0, f32x16& p1, float alpha, float& l_reg, bf16x8& pa0, bf16x8& pa1, bf16x8& pa2, bf16x8& pa3) {
#pragma unroll
  for (int r = 0; r < 16; ++r) p1[r] = __builtin_amdgcn_exp2f(p1[r]);
  float ps = 0;
#pragma unroll
  for (int r = 0; r < 16; ++r) ps += p0[r];
#pragma unroll
  for (int r = 0; r < 16; ++r) ps += p1[r];
  { auto rr = __builtin_amdgcn_permlane32_swap(__float_as_uint(ps), __float_as_uint(ps), false, false);
    ps = __uint_as_float(rr[0]) + __uint_as_float(rr[1]); }
  l_reg = l_reg * alpha + ps;
  PK4(p0, 0, pa0); PK4(p0, 8, pa1); PK4(p1, 0, pa2); PK4(p1, 8, pa3);
}

template <int DQK, bool PIPE>
DEVI void attn_body(const u16* __restrict__ Qb, int ldq, const u16* __restrict__ K0, int ldk0, const u16* __restrict__ K1, int ldk1,
                    const u16* __restrict__ Vh, int ldv, u16* __restrict__ Ob, int ldo, int seq, float scale, char* lds) {
  constexpr int KRB = DQK * 2, SHM_K = 64 * KRB, SHM_V = 16384, ND0 = DQK / 16, NCH = DQK / 8, NKC = (64 * NCH) / NTHREADS;
  const int tid = otid(), wid = tid >> 6, lane = tid & 63, r32 = lane & 31, hi = lane >> 5;
  char* V_lds = lds; char* K_lds = lds + 2 * SHM_V;
  float* wsf = (float*)(lds + 2 * SHM_V + 2 * SHM_K) + wid * 64; float* li_l = wsf; float* al_l = wsf + 32;
  float m_reg = -1e30f, l_reg = 0; f32x16 o[4];
#pragma unroll
  for (int d = 0; d < 4; ++d)
#pragma unroll
    for (int r = 0; r < 16; ++r) o[d][r] = 0.f;
  bf16x8 qr[ND0];
  const u16* Qw = Qb + (long)(wid * 32 + r32) * ldq + hi * 8;
#pragma unroll
  for (int d0 = 0; d0 < ND0; ++d0) qr[d0] = *(const bf16x8*)(Qw + d0 * 16);
  const int sr = tid >> 4, sc = (tid & 15) * 8, vst0 = v_st(sr, sc), vst1 = v_st(32 + sr, sc);
  const int vb0 = (int)(uintptr_t)V_lds + v_rd_base(lane);
  bf16x8 vs0, vs1, ksg[NKC];
  const int krow0 = (DQK == 64) ? (tid >> 3) : (tid >> 4), kchk0 = (DQK == 64) ? (tid & 7) : (tid & 15);
  const u16* kp0 = K0 + (long)krow0 * ldk0 + kchk0 * 8;
  const int koff0 = krow0 * KRB + ((kchk0 * 16) ^ (((krow0 >> 1) & 7) << 4));
  const int koff1 = (krow0 + 32) * KRB + ((kchk0 * 16) ^ (((krow0 >> 1) & 7) << 4));
  const int krow2 = tid >> 3, kchk2 = 16 + (tid & 7);
  const u16* kp2 = K1 + (long)krow2 * ldk1 + (tid & 7) * 8;
  const int koff2 = krow2 * KRB + ((kchk2 * 16) ^ (((krow2 >> 1) & 7) << 4));
  const u16* vp0 = Vh + (long)sr * ldv + sc;
#define SLOAD(k0) do { vs0 = *(const bf16x8*)(vp0 + (long)(k0) * ldv); vs1 = *(const bf16x8*)(vp0 + (long)((k0) + 32) * ldv); \
    ksg[0] = *(const bf16x8*)(kp0 + (long)(k0) * ldk0); \
    if constexpr (DQK == 192) { ksg[1] = *(const bf16x8*)(kp0 + (long)((k0) + 32) * ldk0); ksg[2] = *(const bf16x8*)(kp2 + (long)(k0) * ldk1); } } while (0)
#define SWRITE(b) do { *(bf16x8*)(V_lds + (b) * SHM_V + vst0) = vs0; *(bf16x8*)(V_lds + (b) * SHM_V + vst1) = vs1; \
    *(bf16x8*)(K_lds + (b) * SHM_K + koff0) = ksg[0]; \
    if constexpr (DQK == 192) { *(bf16x8*)(K_lds + (b) * SHM_K + koff1) = ksg[1]; *(bf16x8*)(K_lds + (b) * SHM_K + koff2) = ksg[2]; } } while (0)
#define SWAIT() asm volatile("s_waitcnt vmcnt(0)" ::: "memory")
#define RESC(a) do { if (__any((a) < 1.f)) { if (hi == 0) al_l[r32] = (a); asm volatile("s_waitcnt lgkmcnt(0)" ::: "memory"); \
    _Pragma("unroll") for (int d = 0; d < 4; ++d) _Pragma("unroll") for (int r = 0; r < 16; ++r) o[d][r] *= al_l[crow(r, hi)]; } } while (0)
#define QKT(P0, P1, KB) do { _Pragma("unroll") for (int r_ = 0; r_ < 16; ++r_) { P0[r_] = 0.f; P1[r_] = 0.f; } \
    _Pragma("unroll") for (int d0 = 0; d0 < ND0; ++d0) { const int cb_ = (d0 * 16 + hi * 8) * 2; \
      bf16x8 b0_ = *(const bf16x8*)((KB) + r32 * KRB + (cb_ ^ (((r32 >> 1) & 7) << 4))); \
      bf16x8 b1_ = *(const bf16x8*)((KB) + (32 + r32) * KRB + (cb_ ^ (((r32 >> 1) & 7) << 4))); \
      P0 = __builtin_amdgcn_mfma_f32_32x32x16_bf16(b0_, qr[d0], P0, 0, 0, 0); \
      P1 = __builtin_amdgcn_mfma_f32_32x32x16_bf16(b1_, qr[d0], P1, 0, 0, 0); } } while (0)
  bf16x8 pa0, pa1, pa2, pa3; const int NT = seq / 64;
  if constexpr (PIPE) {
    f32x16 pA0, pA1, pB0, pB1; float mnA, mnB, alA, alB;
    SLOAD(0); SWAIT(); SWRITE(0); __syncthreads();
    QKT(pA0, pA1, K_lds); partialSM(pA0, pA1, m_reg, mnA, alA, scale);
    SLOAD(64);
    SWAIT(); SWRITE(1); __syncthreads();
    for (int j = 1; j + 1 < NT; j += 2) {
      SBAR(); QKT(pB0, pB1, K_lds + SHM_K);
      finishSM(pA0, pA1, alA, l_reg, pa0, pa1, pa2, pa3); SBAR();
      SLOAD((j + 1) * 64); SBAR();
      pv_d0(o, vb0, pa0, pa1, pa2, pa3); partialSM(pB0, pB1, m_reg, mnB, alB, scale);
      __syncthreads(); SWAIT(); SWRITE(0);
      RESC(alB); __syncthreads();
      SBAR(); QKT(pA0, pA1, K_lds);
      finishSM(pB0, pB1, alB, l_reg, pa0, pa1, pa2, pa3); SBAR();
      SLOAD((j + 2) * 64); SBAR();
      pv_d0(o, vb0 + SHM_V, pa0, pa1, pa2, pa3); partialSM(pA0, pA1, m_reg, mnA, alA, scale);
      __syncthreads(); SWAIT(); SWRITE(1);
      RESC(alA); __syncthreads();
    }
    SBAR(); QKT(pB0, pB1, K_lds + SHM_K);
    finishSM(pA0, pA1, alA, l_reg, pa0, pa1, pa2, pa3); SBAR();
    pv_d0(o, vb0, pa0, pa1, pa2, pa3); partialSM(pB0, pB1, m_reg, mnB, alB, scale);
    __syncthreads(); RESC(alB);
    finishSM(pB0, pB1, alB, l_reg, pa0, pa1, pa2, pa3); SBAR();
    pv_d0(o, vb0 + SHM_V, pa0, pa1, pa2, pa3);
  } else {
    f32x16 p0, p1; float mn, al;
    SLOAD(0); SWAIT(); SWRITE(0); __syncthreads();
    for (int j = 0; j < NT; ++j) {
      const int bsel = j & 1;
      if (j + 1 < NT) SLOAD((j + 1) * 64);
      SBAR(); QKT(p0, p1, K_lds + bsel * SHM_K);
      partialSM(p0, p1, m_reg, mn, al, scale);
      RESC(al);
      finishSM(p0, p1, al, l_reg, pa0, pa1, pa2, pa3); SBAR();
      pv_d0(o, vb0 + bsel * SHM_V, pa0, pa1, pa2, pa3);
      if (j + 1 < NT) { SWAIT(); SWRITE(bsel ^ 1); }
      __syncthreads();
    }
  }
  if (hi == 0) li_l[r32] = l_reg; asm volatile("s_waitcnt lgkmcnt(0)" ::: "memory");
  float rli[16];
#pragma unroll
  for (int r = 0; r < 16; ++r) rli[r] = __builtin_amdgcn_rcpf(li_l[crow(r, hi)]);
  u16* Ow = Ob + (long)(wid * 32) * ldo;
#pragma unroll
  for (int r = 0; r < 16; ++r) { const int orow = crow(r, hi);
#pragma unroll
    for (int d0 = 0; d0 < 4; ++d0) Ow[(long)orow * ldo + d0 * 32 + r32] = f2bf(o[d0][r] * rli[r]); }
  __syncthreads();
#undef SLOAD
#undef SWRITE
#undef SWAIT
#undef RESC
#undef QKT
}

DEVI long gla_row(int bi, int dir, int cc, int i) {
  const int L = (cc < 4) ? CTXL : SEQ, c = (cc < 4) ? cc : cc - 4, rb = bi * ROWS + ((cc < 4) ? SEQ : 0);
  const int tl = c * 64 + i;
  return (long)(rb + (dir ? (L - 1 - tl) : tl));
}
DEVI void gla_seq(const Params& p, int l, int item, char* lds) {
  const int tid = otid(), wid = tid >> 6, lane = tid & 63, r32 = lane & 31, hi = lane >> 5;
  const int bi = item >> 5, h = (item >> 3) & 3, dir = (item >> 2) & 1, sl = item & 3;
  char* qs = lds;
  char* ks = lds + 16384;
  char* kT = lds + 32768;
  char* vT = lds + 32768 + 18432;
  char* sT = lds + 32768 + 18432 + 9216;
  float* gas = (float*)(sT + 32768);
  float* segtot = gas + 1024;
  float* ebl = segtot + 512;
  const u16* feat = (const u16*)(p.ws + OFF_FEAT);
  u16* og = (u16*)(p.ws + OFF_OG) + (long)dir * RP * 1024;
  const int d = tid & 127, seg = tid >> 7;
  float w2[16];
#pragma unroll
  for (int r = 0; r < 16; ++r) w2[r] = p.gla_w_a2[(((long)l * 2 + dir) * 16 + r) * 512 + h * 128 + d];
  const float ba = p.gla_b_a[((long)l * 2 + dir) * 512 + h * 128 + d];
  __syncthreads();
  for (int i = tid; i < 8192; i += NTHREADS) ((unsigned*)sT)[i] = 0u;
  f32x16 Sacc;
#pragma unroll
  for (int r = 0; r < 16; ++r) Sacc[r] = 0.f;
  const int dblk = wid >> 1, eblk = wid & 1, iblk = (wid >> 1) & 1;
  u32x4 pq0, pq1, pk0, pk1, pv; u16 pg0, pg1;
  const int row0 = tid >> 4, chq = tid & 15;
  const int vi0 = tid >> 3, ve8 = (tid & 7) * 8;
  const int g0i = (tid * 2) >> 4, g0r = (tid * 2) & 15;
#define GLOADC(cc_) do { \
    const u16* f0_ = feat + gla_row(bi, dir, (cc_), row0) * NF + h * 128 + chq * 8; \
    const u16* f1_ = feat + gla_row(bi, dir, (cc_), 32 + row0) * NF + h * 128 + chq * 8; \
    pq0 = *(const u32x4*)(f0_ + F_GQ); pk0 = *(const u32x4*)(f0_ + F_GK); pq1 = *(const u32x4*)(f1_ + F_GQ); pk1 = *(const u32x4*)(f1_ + F_GK); \
    pv = *(const u32x4*)(feat + gla_row(bi, dir, (cc_), vi0) * NF + F_GV + h * 256 + sl * 64 + ve8); \
    const u16* g_ = feat + gla_row(bi, dir, (cc_), g0i) * NF + F_GA + dir * 16 + g0r; pg0 = g_[0]; pg1 = g_[1]; } while (0)
  GLOADC(0);
  int cur = 0;
  for (int cc = 0; cc < 132; ++cc) {
    {
      const int so0 = row0 * 256 + ((chq ^ (row0 & 7)) << 4), so1 = so0 + 32 * 256;
      *(u32x4*)(qs + so0) = pq0; *(u32x4*)(ks + so0) = pk0; *(u32x4*)(qs + so1) = pq1; *(u32x4*)(ks + so1) = pk1;
#pragma unroll
      for (int j = 0; j < 4; ++j) {
        *(u16*)(vT + (ve8 + 2 * j) * 144 + vi0 * 2) = (u16)(pv[j] & 0xffffu);
        *(u16*)(vT + (ve8 + 2 * j + 1) * 144 + vi0 * 2) = (u16)(pv[j] >> 16);
      }
      gas[tid * 2] = bf2f(pg0); gas[tid * 2 + 1] = bf2f(pg1);
    }
    __syncthreads();
    if (cc + 1 < 132) GLOADC(cc + 1);
    SBAR();
    float bcum[16];
    {
      float run = 0.f;
#pragma unroll
      for (int ii = 0; ii < 16; ++ii) {
        const float* gr_ = gas + (seg * 16 + ii) * 16;
        float z = ba;
#pragma unroll
        for (int r = 0; r < 16; ++r) z += gr_[r] * w2[r];
        const float ls = fminf(z, 0.f) - __logf(1.f + __expf(-fabsf(z)));
        run += ls * (1.f / 16.f);
        bcum[ii] = run;
      }
      segtot[seg * 128 + d] = run;
    }
    __syncthreads();
    {
      float pre = 0.f, tot = 0.f;
#pragma unroll
      for (int s_ = 0; s_ < 4; ++s_) { const float v = segtot[s_ * 128 + d]; tot += v; if (s_ < seg) pre += v; }
      const float etot = __expf(tot);
      if (seg == 0) ebl[d] = etot;
#pragma unroll
      for (int ii = 0; ii < 16; ++ii) {
        const int i = seg * 16 + ii;
        const float bb = bcum[ii] + pre;
        const int so = i * 256 + (((d >> 3) ^ (i & 7)) << 4) + (d & 7) * 2;
        const float q = bf2f(*(const u16*)(qs + so)), k = bf2f(*(const u16*)(ks + so));
        const float eb = __expf(bb), ieb = __frcp_rn(eb);
        *(u16*)(qs + so) = f2bf(q * eb);
        *(u16*)(ks + so) = f2bf(k * ieb);
        *(u16*)(kT + d * 144 + i * 2) = f2bf(k * (etot * ieb));
      }
    }
    __syncthreads();
    const char* sTc = sT + cur * 16384; char* sTn = sT + (cur ^ 1) * 16384;
    if (wid < 4) {
      f32x16 p0, p1, o;
#pragma unroll
      for (int r = 0; r < 16; ++r) { p0[r] = 0.f; p1[r] = 0.f; o[r] = 0.f; }
      const int irow = iblk * 32 + r32;
#pragma unroll
      for (int d0 = 0; d0 < 8; ++d0) {
        const int chn = d0 * 2 + hi;
        const bf16x8 b0 = *(const bf16x8*)(ks + r32 * 256 + ((chn ^ (r32 & 7)) << 4));
        const bf16x8 b1 = *(const bf16x8*)(ks + (32 + r32) * 256 + ((chn ^ (r32 & 7)) << 4));
        const bf16x8 qf = *(const bf16x8*)(qs + irow * 256 + ((chn ^ (irow & 7)) << 4));
        p0 = __builtin_amdgcn_mfma_f32_32x32x16_bf16(b0, qf, p0, 0, 0, 0);
        p1 = __builtin_amdgcn_mfma_f32_32x32x16_bf16(b1, qf, p1, 0, 0, 0);
      }
#pragma unroll
      for (int r = 0; r < 16; ++r) {
        const int j0 = crow(r, hi), j1 = 32 + j0;
        const bool k0 = dir ? (j0 < irow) : (j0 <= irow), k1 = dir ? (j1 < irow) : (j1 <= irow);
        p0[r] = k0 ? p0[r] : 0.f; p1[r] = k1 ? p1[r] : 0.f;
      }
      bf16x8 pa0, pa1, pa2, pa3;
      PK4(p0, 0, pa0); PK4(p0, 8, pa1); PK4(p1, 0, pa2); PK4(p1, 8, pa3);
      const char* vrow = vT + (eblk * 32 + r32) * 144 + hi * 16;
      o = __builtin_amdgcn_mfma_f32_32x32x16_bf16(pa0, *(const bf16x8*)(vrow), o, 0, 0, 0);
      o = __builtin_amdgcn_mfma_f32_32x32x16_bf16(pa1, *(const bf16x8*)(vrow + 32), o, 0, 0, 0);
      o = __builtin_amdgcn_mfma_f32_32x32x16_bf16(pa2, *(const bf16x8*)(vrow + 64), o, 0, 0, 0);
      o = __builtin_amdgcn_mfma_f32_32x32x16_bf16(pa3, *(const bf16x8*)(vrow + 96), o, 0, 0, 0);
      const int erow = eblk * 32 + r32;
#pragma unroll
      for (int d0 = 0; d0 < 8; ++d0) {
        const int chn = d0 * 2 + hi;
        const bf16x8 qf = *(const bf16x8*)(qs + irow * 256 + ((chn ^ (irow & 7)) << 4));
        const bf16x8 sf = *(const bf16x8*)(sTc + erow * 256 + ((chn ^ (erow & 7)) << 4));
        o = __builtin_amdgcn_mfma_f32_32x32x16_bf16(qf, sf, o, 0, 0, 0);
      }
#pragma unroll
      for (int r = 0; r < 16; ++r)
        og[gla_row(bi, dir, cc, iblk * 32 + crow(r, hi)) * 1024 + h * 256 + sl * 64 + eblk * 32 + r32] = f2bf(o[r]);
    }
    {
#pragma unroll
      for (int r = 0; r < 16; ++r) Sacc[r] *= ebl[dblk * 32 + crow(r, hi)];
      const char* krow = kT + (dblk * 32 + r32) * 144 + hi * 16;
      const char* vrow = vT + (eblk * 32 + r32) * 144 + hi * 16;
#pragma unroll
      for (int k16 = 0; k16 < 4; ++k16)
        Sacc = __builtin_amdgcn_mfma_f32_32x32x16_bf16(*(const bf16x8*)(krow + k16 * 32), *(const bf16x8*)(vrow + k16 * 32), Sacc, 0, 0, 0);
      const int erow = eblk * 32 + r32;
#pragma unroll
      for (int q4 = 0; q4 < 4; ++q4) {
        const int chn = dblk * 4 + q4;
        u32x2 w = {cvtpk(Sacc[q4 * 4 + 0], Sacc[q4 * 4 + 1]), cvtpk(Sacc[q4 * 4 + 2], Sacc[q4 * 4 + 3])};
        *(u32x2*)(sTn + erow * 256 + ((chn ^ (erow & 7)) << 4) + hi * 8) = w;
      }
    }
    cur ^= 1;
    __syncthreads();
  }
#undef GLOADC
}

DEVI void phase_mix(const Params& p, int ps, int l, char* lds) {
  __shared__ int s_q;
  const u16* feat = (const u16*)(p.ws + OFF_FEAT);
  const u16* qm = (const u16*)(p.ws + OFF_QM);
  const u16* kvb = (const u16*)(p.ws + OFF_KV);
  u16* od = (u16*)(p.ws + OFF_OD);
  u16* yc = (u16*)(p.ws + OFF_YC);
  const int x = blockIdx.x & 7, jb = blockIdx.x >> 3;
  if (jb < 8) gla_seq(p, l, x * 8 + jb, lds);
  int* ctr = (int*)(p.ws + OFF_CTR) + 128 + (ps * 2 + l) * 8 + x;
  const int nmla = NBP * 32, ndiff = NBP * 64, nctx = (l == 0) ? (NBP * 24 / 8) : 0;
  for (;;) {
    __syncthreads();
    if (otid() == 0) s_q = atomicAdd(ctr, 1);
    __syncthreads();
    const int q = s_q;
    if (q >= nmla) break;
    const int bi = q >> 5, h = x, q0 = bi * ROWS + (q & 31) * 256;
    const long k0 = (long)bi * ROWS;
    attn_body<192, false>(qm + (long)q0 * 1536 + h * 192, 1536, kvb + k0 * 2048 + h * 256, 2048, feat + k0 * NF + F_KR, NF,
                          kvb + k0 * 2048 + h * 256 + 128, 2048, yc + (long)q0 * 1024 + h * 128, 1024, ROWS, 0.07216878364870322f, lds);
  }
  int* ctr2 = ctr + 128;
  for (;;) {
    __syncthreads();
    if (otid() == 0) s_q = atomicAdd(ctr2, 1);
    __syncthreads();
    const int q = s_q;
    if (q >= ndiff + nctx) break;
    if (q < ndiff) {
      const int bi = q >> 6, hm = x + 8 * ((q >> 5) & 1), h = hm >> 1, mp = hm & 1, q0 = bi * ROWS + (q & 31) * 256;
      const long k0 = (long)bi * ROWS;
      attn_body<64, true>(feat + (long)q0 * NF + F_DQ + h * 128 + mp * 64, NF, feat + k0 * NF + F_DK + h * 128 + mp * 64, NF, feat, NF,
                          feat + k0 * NF + F_DV + h * 128, NF, od + (long)mp * RP * 1024 + (long)q0 * 1024 + h * 128, 1024, ROWS, 0.125f, lds);
    } else {
      const int u = (q - ndiff) * 8 + x, bi = u / 24, v = u % 24;
      const long c0 = (long)bi * ROWS + SEQ;
      if (v < 8) {
        const int h = v;
        attn_body<192, false>(qm + c0 * 1536 + h * 192, 1536, kvb + c0 * 2048 + h * 256, 2048, feat + c0 * NF + F_KR, NF,
                              kvb + c0 * 2048 + h * 256 + 128, 2048, yc + c0 * 1024 + h * 128, 1024, CTXL, 0.07216878364870322f, lds);
      } else {
        const int h = (v - 8) >> 1, mp = (v - 8) & 1;
        attn_body<64, true>(feat + c0 * NF + F_DQ + h * 128 + mp * 64, NF, feat + c0 * NF + F_DK + h * 128 + mp * 64, NF, feat, NF,
                            feat + c0 * NF + F_DV + h * 128, NF, od + (long)mp * RP * 1024 + c0 * 1024 + h * 128, 1024, CTXL, 0.125f, lds);
      }
    }
  }
}

DEVI void grid_bar(unsigned* ctr, unsigned& epoch) {
  asm volatile("s_waitcnt vmcnt(0)" ::: "memory");
  __syncthreads();
  if (threadIdx.x == 0) {
    __builtin_amdgcn_fence(__ATOMIC_RELEASE, "agent");
    asm volatile("s_waitcnt vmcnt(0)" ::: "memory");
    __hip_atomic_fetch_add(ctr, 1u, __ATOMIC_RELAXED, __HIP_MEMORY_SCOPE_AGENT);
    const unsigned target = (epoch + 1u) * gridDim.x;
    while (__hip_atomic_load(ctr, __ATOMIC_RELAXED, __HIP_MEMORY_SCOPE_AGENT) < target) __builtin_amdgcn_s_sleep(1);
    __builtin_amdgcn_fence(__ATOMIC_ACQUIRE, "agent");
    asm volatile("s_waitcnt vmcnt(0)" ::: "memory");
  }
  __syncthreads();
  ++epoch;
}

__global__ void __launch_bounds__(NTHREADS) fwd_megakernel(Params p) {
  extern __shared__ __attribute__((aligned(16))) char lds[];
  cg::grid_group grid = cg::this_grid();
  if (blockIdx.x == 0) ((int*)(p.ws + OFF_CTR))[threadIdx.x] = 0;
  unsigned* gbar = (unsigned*)(p.ws + OFF_CTR) + 96; unsigned epoch = 0;
  for (int l = 0; l < 2; ++l) {
    conv_weight(p.w_in + (long)l * 1024 * NIN_ORIG, NIN_ORIG, (u16*)(p.ws + OFF_WIN) + (long)l * NF * 1024, NF, 1024, 1, nullptr, lds);
    conv_weight(p.mla_w_uq + (long)l * 256 * 1536, 1536, (u16*)(p.ws + OFF_WUQ) + (long)l * 1536 * 256, 1536, 256, 0, p.mla_q_norm_g + l * 256, lds);
    conv_weight(p.mla_w_ukv + (long)l * 128 * 2048, 2048, (u16*)(p.ws + OFF_WUKV) + (long)l * 2048 * 128, 2048, 128, 0, p.mla_kv_norm_g + l * 128, lds);
    for (int i = 0; i < 3; ++i)
      conv_weight(p.w_branch + ((long)l * 3 + i) * 1024 * 1024, 1024, (u16*)(p.ws + OFF_WBR) + ((long)l * 3 + i) * 1024 * 1024, 1024, 1024, 0, nullptr, lds);
    conv_weight(p.w_out + (long)l * 1024 * 1024, 1024, (u16*)(p.ws + OFF_WOUT) + (long)l * 1024 * 1024, 1024, 1024, 0, nullptr, lds);
    conv_weight(p.ffn_w_in + (long)l * 1024 * 5632, 5632, (u16*)(p.ws + OFF_WF1) + (long)l * 5632 * 1024, 5632, 1024, 2, nullptr, lds);
    conv_weight(p.ffn_w_out + (long)l * FH * 1024, 1024, (u16*)(p.ws + OFF_WF2) + (long)l * 1024 * FH, 1024, FH, 0, nullptr, lds);
  }
  phase_modv(p, lds);
  phase_rope(p);
  grid.sync();
  phase_mod1_l0(p, 0);
  grid_bar(gbar, epoch);
  for (int ps = 0; ps < NPASS; ++ps) {
    for (int l = 0; l < 2; ++l) {
      phase_gemm_in(p, l, lds);              grid_bar(gbar, epoch);
      phase_gemm_up(p, l, lds);              grid_bar(gbar, epoch);
      phase_mix(p, ps, l, lds);              grid_bar(gbar, epoch);
      phase_prep(p, l);                      grid_bar(gbar, epoch);
      phase_gemm_br(p, l, lds);              grid_bar(gbar, epoch);
      phase_gemm_res(p, ps, l, 2, lds);      grid_bar(gbar, epoch);
      phase_rows_a(p, ps, l);                grid_bar(gbar, epoch);
      phase_gemm_f1(p, l, lds);              grid_bar(gbar, epoch);
      phase_gemm_res(p, ps, l, 5, lds);      grid_bar(gbar, epoch);
      phase_rows_b(p, ps, l);                if (!(ps == NPASS - 1 && l == 1)) grid_bar(gbar, epoch);
    }
  }
}

extern "C" void kernel_launch(void* const* d_in, const int* in_sizes, int n_in, void* d_out, int out_size, void* d_ws, size_t ws_size, hipStream_t stream) {
  static int grid_blocks = 0;
  if (grid_blocks == 0) {
    if (n_in != 24 || ws_size < WS_END) { fprintf(stderr, "kernel_launch: n_in %d ws %zu need %zu\n", n_in, ws_size, (size_t)WS_END); grid_blocks = -1; return; }
    int dev = 0, cus = 0, per_cu = 0;
    hipGetDevice(&dev);
    hipDeviceGetAttribute(&cus, hipDeviceAttributeMultiprocessorCount, dev);
    if (hipFuncSetAttribute((const void*)fwd_megakernel, hipFuncAttributeMaxDynamicSharedMemorySize, LDS_BYTES) != hipSuccess) { fprintf(stderr, "kernel_launch: LDS attr failed\n"); grid_blocks = -1; return; }
    hipOccupancyMaxActiveBlocksPerMultiprocessor(&per_cu, (const void*)fwd_megakernel, NTHREADS, LDS_BYTES);
    if (per_cu < 1) { fprintf(stderr, "kernel_launch: occupancy %d\n", per_cu); per_cu = 1; }
    if (per_cu > 1) per_cu = 1;
    grid_blocks = cus * per_cu;
  }
  if (grid_blocks < 0) return;
  Params p{};
  const float** pp = (const float**)&p;
  for (int i = 0; i < 24; ++i) pp[i] = (const float*)d_in[i];
  p.out = (float*)d_out; p.ws = (char*)d_ws;
  void* args[] = {&p};
  hipError_t e = hipLaunchCooperativeKernel((const void*)fwd_megakernel, dim3(grid_blocks), dim3(NTHREADS), args, LDS_BYTES, stream);
  if (e != hipSuccess) fprintf(stderr, "cooperative launch failed: %s (grid %d)\n", hipGetErrorString(e), grid_blocks);
}
```

```cpp
#include <hip/hip_runtime.h>
#include <hip/hip_bf16.h>
#include <hip/hip_cooperative_groups.h>
#include <cstdio>
#include <cstdint>
namespace cg = cooperative_groups;

#define DEVI __device__ __forceinline__
typedef unsigned short u16;
typedef __attribute__((ext_vector_type(8))) short bf16x8;
typedef __attribute__((ext_vector_type(4))) short s16x4;
typedef __attribute__((ext_vector_type(16))) float f32x16;
typedef __attribute__((ext_vector_type(4))) float f32x4;
typedef __attribute__((ext_vector_type(4))) unsigned u32x4;
typedef __attribute__((ext_vector_type(2))) unsigned u32x2;

constexpr int DM = 1024, NBATCH = 8, SEQ = 8192, CTXL = 256, ROWS = SEQ + CTXL;
constexpr int NF = 9728;
constexpr int F_GQ = 0, F_GK = 512, F_GV = 1024, F_GR = 2048, F_DQ = 3072, F_DK = 4096, F_DV = 5120, F_MQ = 6144, F_MKV = 6400,
              F_GATE = 6528, F_KR = 9600, F_GA = 9664;
constexpr int FH = 2816;
constexpr int NIN_ORIG = 9696;
constexpr float ALPHA = 1.4142135623730951f;
constexpr float EPS = 1e-6f;
constexpr int NTHREADS = 512;
constexpr int NBP = 2, RP = NBP * ROWS, NPASS = NBATCH / NBP;

constexpr size_t al256(size_t x) { return (x + 255) / 256 * 256; }
constexpr size_t OFF_WIN  = 0;
constexpr size_t OFF_WUQ  = OFF_WIN  + al256((size_t)2 * NF * 1024 * 2);
constexpr size_t OFF_WUKV = OFF_WUQ  + al256((size_t)2 * 1536 * 256 * 2);
constexpr size_t OFF_WBR  = OFF_WUKV + al256((size_t)2 * 2048 * 128 * 2);
constexpr size_t OFF_WOUT = OFF_WBR  + al256((size_t)2 * 3 * 1024 * 1024 * 2);
constexpr size_t OFF_WF1  = OFF_WOUT + al256((size_t)2 * 1024 * 1024 * 2);
constexpr size_t OFF_WF2  = OFF_WF1  + al256((size_t)2 * 5632 * 1024 * 2);
constexpr size_t OFF_MODV = OFF_WF2  + al256((size_t)2 * 1024 * 2816 * 2);
constexpr size_t OFF_ROPE = OFF_MODV + al256((size_t)2 * 9 * 6144 * 4);
constexpr size_t OFF_CTR  = OFF_ROPE + al256((size_t)SEQ * 64 * 4);
constexpr size_t OFF_XC   = OFF_CTR  + 2048;
constexpr size_t OFF_H    = OFF_XC   + al256((size_t)NBP * CTXL * 1024 * 4);
constexpr size_t OFF_FEAT = OFF_H    + al256((size_t)RP * 1024 * 2);
constexpr size_t OFF_QM   = OFF_FEAT + al256((size_t)RP * NF * 2);
constexpr size_t OFF_KV   = OFF_QM   + al256((size_t)RP * 1536 * 2);
constexpr size_t OFF_OG   = OFF_KV   + al256((size_t)RP * 2048 * 2);
constexpr size_t OFF_OD   = OFF_OG   + al256((size_t)2 * RP * 1024 * 2);
constexpr size_t OFF_YC   = OFF_OD   + al256((size_t)2 * RP * 1024 * 2);
constexpr size_t WS_END   = OFF_YC   + al256((size_t)RP * 1024 * 2);
constexpr size_t OFF_YA   = OFF_OG;
constexpr size_t OFF_YB   = OFF_OD;
constexpr size_t OFF_Y    = OFF_H;
constexpr size_t OFF_HID  = OFF_FEAT;

constexpr int LDS_BYTES = 140 * 1024;

struct Params {
  const float *x, *c, *ctx, *c_ctx, *w_mod, *b_mod, *w_in, *gla_w_a2, *gla_b_a, *gla_norm_g, *diff_lam, *diff_norm_g,
      *mla_q_norm_g, *mla_kv_norm_g, *mla_w_uq, *mla_w_ukv, *w_branch, *w_out, *ln1_g, *ln1_b, *ffn_w_in, *ffn_w_out, *ln2_g, *ln2_b;
  float* out;
  char* ws;
};

typedef float f32x2_t __attribute__((ext_vector_type(2)));
typedef __bf16 bf16x2_t __attribute__((ext_vector_type(2)));
DEVI unsigned cvtpk(float lo, float hi) { f32x2_t v = {lo, hi}; bf16x2_t b = __builtin_convertvector(v, bf16x2_t); return __builtin_bit_cast(unsigned, b); }
DEVI u16 f2bf(float f) { return (u16)(cvtpk(f, 0.f) & 0xffffu); }
DEVI float bf2f(u16 h) { return __uint_as_float(((unsigned)h) << 16); }
DEVI float bflo(unsigned w) { return __uint_as_float(w << 16); }
DEVI float bfhi(unsigned w) { return __uint_as_float(w & 0xffff0000u); }
DEVI void st4bf(u16* p, float a, float b, float c, float d) { u32x2 w = {cvtpk(a, b), cvtpk(c, d)}; *(u32x2*)p = w; }
DEVI float wave_sum(float v) {
#pragma unroll
  for (int m = 32; m >= 1; m >>= 1) v += __shfl_xor(v, m);
  return v;
}
DEVI float siluf(float x) { return x / (1.f + expf(-x)); }
DEVI float sigmf(float x) { return 1.f / (1.f + expf(-x)); }
DEVI int crow(int r, int hi) { return (r & 3) + 8 * (r >> 2) + 4 * hi; }
#define SBAR() __builtin_amdgcn_sched_barrier(0)

DEVI int vblock() { return (int)(blockIdx.x & 7) * (int)(gridDim.x >> 3) + (int)(blockIdx.x >> 3); }
DEVI void tile_map(int t, int NTM, int NTN, int& tm, int& tn) {
  const int per = NTM * 4, g = t / per, r = t - g * per;
  const int w = (NTN - g * 4) < 4 ? (NTN - g * 4) : 4;
  tm = r / w; tn = g * 4 + (r - tm * w);
}
DEVI int otid() { int t = threadIdx.x; asm volatile("" : "+v"(t)); return t; }

template <int MI, int NC>
DEVI void mfma_tile(f32x16 (&acc)[2 * NC][MI], const char* Ab, const char* Bb, int rowa0, int rowb0, int sa, int sb, int hi) {
  if constexpr (MI * NC >= 4) {
#pragma unroll
    for (int k16 = 0; k16 < 4; ++k16) {
      const int chn = k16 * 2 + hi;
      bf16x8 ga[2 * NC], gb[MI];
#pragma unroll
      for (int ni = 0; ni < 2 * NC; ++ni) ga[ni] = *(const bf16x8*)(Bb + (rowa0 + 32 * ni) * 128 + ((chn ^ sa) << 4));
#pragma unroll
      for (int mi = 0; mi < MI; ++mi) gb[mi] = *(const bf16x8*)(Ab + (rowb0 + 32 * mi) * 128 + ((chn ^ sb) << 4));
#pragma unroll
      for (int ni = 0; ni < 2 * NC; ++ni)
#pragma unroll
        for (int mi = 0; mi < MI; ++mi)
          acc[ni][mi] = __builtin_amdgcn_mfma_f32_32x32x16_bf16(ga[ni], gb[mi], acc[ni][mi], 0, 0, 0);
    }
    return;
  }
  bf16x8 fa[2][2 * NC], fb[2][MI];
#pragma unroll
  for (int ni = 0; ni < 2 * NC; ++ni) fa[0][ni] = *(const bf16x8*)(Bb + (rowa0 + 32 * ni) * 128 + ((hi ^ sa) << 4));
#pragma unroll
  for (int mi = 0; mi < MI; ++mi) fb[0][mi] = *(const bf16x8*)(Ab + (rowb0 + 32 * mi) * 128 + ((hi ^ sb) << 4));
#pragma unroll
  for (int k16 = 0; k16 < 4; ++k16) {
    if (k16 < 3) {
      const int chn = (k16 + 1) * 2 + hi;
#pragma unroll
      for (int ni = 0; ni < 2 * NC; ++ni) fa[(k16 + 1) & 1][ni] = *(const bf16x8*)(Bb + (rowa0 + 32 * ni) * 128 + ((chn ^ sa) << 4));
#pragma unroll
      for (int mi = 0; mi < MI; ++mi) fb[(k16 + 1) & 1][mi] = *(const bf16x8*)(Ab + (rowb0 + 32 * mi) * 128 + ((chn ^ sb) << 4));
    }
    SBAR();
#pragma unroll
    for (int ni = 0; ni < 2 * NC; ++ni)
#pragma unroll
      for (int mi = 0; mi < MI; ++mi)
        acc[ni][mi] = __builtin_amdgcn_mfma_f32_32x32x16_bf16(fa[k16 & 1][ni], fb[k16 & 1][mi], acc[ni][mi], 0, 0, 0);
    SBAR();
  }
}

template <int MI, int NC>
DEVI void gemm_kloop(f32x16 (&acc)[2 * NC][MI], const u16* __restrict__ A, long lda, const u16* __restrict__ Bt, long ldb, int K, char* lds) {
  const int tid = otid(), wid = tid >> 6, lane = tid & 63, r32 = lane & 31, hi = lane >> 5;
  const int wm = wid & 3, wn = wid >> 2;
  constexpr int ABUF = 32768, BBUF = 16384 * NC;
  char* As = lds; char* Bs = lds + 65536;
  const int ch = tid & 7, rw = tid >> 3;
  const int swz = ((ch ^ ((rw >> 1) & 7)) << 4);
  u32x4 ra[2 * MI], rb[2 * NC];
  const u16* Ap = A + (long)rw * lda + ch * 8;
  const u16* Bp = Bt + (long)rw * ldb + ch * 8;
#define GLOAD(k0) do { _Pragma("unroll") for (int i_ = 0; i_ < 2 * MI; ++i_) ra[i_] = *(const u32x4*)(Ap + (long)(64 * i_) * lda + (k0)); \
    _Pragma("unroll") for (int i_ = 0; i_ < 2 * NC; ++i_) rb[i_] = *(const u32x4*)(Bp + (long)(64 * i_) * ldb + (k0)); } while (0)
#define GWRITE(buf) do { char* a_ = As + (buf) * ABUF + rw * 128 + swz; char* b_ = Bs + (buf) * BBUF + rw * 128 + swz; \
    _Pragma("unroll") for (int i_ = 0; i_ < 2 * MI; ++i_) *(u32x4*)(a_ + i_ * 64 * 128) = ra[i_]; \
    _Pragma("unroll") for (int i_ = 0; i_ < 2 * NC; ++i_) *(u32x4*)(b_ + i_ * 64 * 128) = rb[i_]; } while (0)
#pragma unroll
  for (int i = 0; i < 2 * NC; ++i)
#pragma unroll
    for (int j = 0; j < MI; ++j)
#pragma unroll
      for (int r = 0; r < 16; ++r) acc[i][j][r] = 0.f;
  const int KT = K >> 6;
  const int grp = __builtin_amdgcn_readfirstlane(wid) >> 2;
  const int rowa0 = wn * (64 * NC) + r32, rowb0 = wm * (32 * MI) + r32;
  const int sa = (rowa0 >> 1) & 7, sb = (rowb0 >> 1) & 7;
#define MFMA_ALL(kt_) mfma_tile<MI, NC>(acc, As + ((kt_) & 1) * ABUF, Bs + ((kt_) & 1) * BBUF, rowa0, rowb0, sa, sb, hi)
#define KBAR() do { asm volatile("s_waitcnt lgkmcnt(0)" ::: "memory"); __builtin_amdgcn_s_barrier(); asm volatile("" ::: "memory"); } while (0)
  GLOAD(0); GWRITE(0); SBAR();
  if (KT > 1) GLOAD(64);
  KBAR();
  if (grp == 0) {
    for (int kt = 0; kt < KT; ++kt) {
      MFMA_ALL(kt);
      KBAR();
      if (kt + 1 < KT) { GWRITE((kt + 1) & 1); if (kt + 2 < KT) GLOAD((kt + 2) * 64); }
      KBAR();
    }
  } else {
    for (int kt = 0; kt < KT; ++kt) {
      if (kt + 1 < KT) { GWRITE((kt + 1) & 1); if (kt + 2 < KT) GLOAD((kt + 2) * 64); }
      KBAR();
      MFMA_ALL(kt);
      KBAR();
    }
  }
#undef KBAR
#undef MFMA_ALL
#undef GLOAD
#undef GWRITE
}

DEVI int map_col(int mode, int n) {
  if (mode == 0) return n;
  if (mode == 1) {
    if (n < 3072) return n;
    if (n < 6528) return n + 32;
    if (n < 9600) return n + 96;
    if (n < 9664) return 6560 + (n - 9600);
    if (n < 9696) return 3072 + (n - 9664);
    return -1;
  }
  const int grp = n >> 6, w = n & 63;
  return (w < 32) ? (grp * 32 + w) : (FH + grp * 32 + (w - 32));
}
DEVI void conv_weight(const float* __restrict__ src, int ldsrc, u16* __restrict__ dst, int Ndst, int K, int mode, const float* __restrict__ kscale, char* lds) {
  float* t = (float*)lds;
  const int tid = otid();
  const int ntn = Ndst >> 6, ntk = K >> 6;
  for (int tile = blockIdx.x; tile < ntn * ntk; tile += gridDim.x) {
    const int n0 = (tile / ntk) << 6, k0 = (tile % ntk) << 6;
    __syncthreads();
#pragma unroll
    for (int it = 0; it < 2; ++it) {
      const int idx = tid + it * NTHREADS, kk = idx >> 4, n4 = (idx & 15) * 4;
      const int sc = map_col(mode, n0 + n4);
      f32x4 v = {0.f, 0.f, 0.f, 0.f};
      if (sc >= 0) v = *(const f32x4*)(src + (long)(k0 + kk) * ldsrc + sc);
      if (kscale) { const float ks = kscale[k0 + kk]; v[0] *= ks; v[1] *= ks; v[2] *= ks; v[3] *= ks; }
      t[(n4 + 0) * 68 + kk] = v[0]; t[(n4 + 1) * 68 + kk] = v[1]; t[(n4 + 2) * 68 + kk] = v[2]; t[(n4 + 3) * 68 + kk] = v[3];
    }
    __syncthreads();
    {
      const int nn = tid >> 3, k8 = (tid & 7) * 8;
      const f32x4 a = *(const f32x4*)(t + nn * 68 + k8), c = *(const f32x4*)(t + nn * 68 + k8 + 4);
      u32x4 w = {cvtpk(a[0], a[1]), cvtpk(a[2], a[3]), cvtpk(c[0], c[1]), cvtpk(c[2], c[3])};
      *(u32x4*)(dst + (long)(n0 + nn) * K + k0 + k8) = w;
    }
  }
  __syncthreads();
}

DEVI void phase_modv(const Params& p, char* lds) {
  float* ca = (float*)lds;
  float* red = ca + 9 * 1024;
  float* modv = (float*)(p.ws + OFF_MODV);
  const int tid = otid();
  __syncthreads();
  for (int i = tid; i < 9 * 1024; i += NTHREADS) {
    const float v = (i < 8192) ? p.c[i] : p.c_ctx[i - 8192];
    ca[i] = siluf(v);
  }
  __syncthreads();
  const int col = tid & 63, ks = tid >> 6;
  for (int tile = blockIdx.x; tile < 2 * 96; tile += gridDim.x) {
    const int l = tile / 96, n0 = (tile % 96) * 64;
    const float* W = p.w_mod + (long)l * 1024 * 6144 + n0 + col;
    float a[9];
#pragma unroll
    for (int j = 0; j < 9; ++j) a[j] = 0.f;
    for (int k = ks * 128; k < ks * 128 + 128; ++k) {
      const float w = W[(long)k * 6144];
#pragma unroll
      for (int j = 0; j < 9; ++j) a[j] += ca[j * 1024 + k] * w;
    }
#pragma unroll
    for (int j = 0; j < 9; ++j) red[(ks * 64 + col) * 9 + j] = a[j];
    __syncthreads();
    for (int i = tid; i < 64 * 9; i += NTHREADS) {
      const int cc = i / 9, j = i % 9;
      float s = 0.f;
      for (int q = 0; q < 8; ++q) s += red[(q * 64 + cc) * 9 + j];
      modv[((long)l * 9 + j) * 6144 + n0 + cc] = s + p.b_mod[l * 6144 + n0 + cc];
    }
    __syncthreads();
  }
}

DEVI void phase_rope(const Params& p) {
  float* rope = (float*)(p.ws + OFF_ROPE);
  for (int i = blockIdx.x * NTHREADS + otid(); i < SEQ * 32; i += gridDim.x * NTHREADS) {
    const int t = i >> 5, f = i & 31;
    const float inv = powf(10000.f, -(float)(f & 15) / 16.f);
    const float pos = (f < 16) ? (float)(t >> 6) : (float)(t & 63);
    const float ang = pos * inv;
    rope[t * 64 + f] = cosf(ang);
    rope[t * 64 + 32 + f] = sinf(ang);
  }
}

DEVI void ln_stats(const float (&v)[16], float& mu, float& rstd) {
  float s = 0.f;
#pragma unroll
  for (int i = 0; i < 16; ++i) s += v[i];
  mu = wave_sum(s) * (1.f / 1024.f);
  float q = 0.f;
#pragma unroll
  for (int i = 0; i < 16; ++i) { const float d = v[i] - mu; q += d * d; }
  rstd = rsqrtf(wave_sum(q) * (1.f / 1024.f) + EPS);
}
DEVI void rowload(const float* __restrict__ src, float (&v)[16]) {
  const int lane = otid() & 63;
#pragma unroll
  for (int i = 0; i < 4; ++i) {
    const f32x4 t = *(const f32x4*)(src + i * 256 + lane * 4);
    v[i * 4 + 0] = t[0]; v[i * 4 + 1] = t[1]; v[i * 4 + 2] = t[2]; v[i * 4 + 3] = t[3];
  }
}
DEVI void rowproc(float (&v)[16], float* __restrict__ dst, const float* __restrict__ ag, const float* __restrict__ ab,
                  u16* __restrict__ hout, const float* __restrict__ sh, const float* __restrict__ sc) {
  const int lane = otid() & 63;
  float mu, rstd;
  if (ag) {
    ln_stats(v, mu, rstd);
#pragma unroll
    for (int i = 0; i < 4; ++i) {
      const f32x4 g = *(const f32x4*)(ag + i * 256 + lane * 4);
      const f32x4 b = *(const f32x4*)(ab + i * 256 + lane * 4);
      f32x4 o;
#pragma unroll
      for (int j = 0; j < 4; ++j) { v[i * 4 + j] = (v[i * 4 + j] - mu) * rstd * g[j] + b[j]; o[j] = v[i * 4 + j]; }
      *(f32x4*)(dst + i * 256 + lane * 4) = o;
    }
  }
  if (hout) {
    ln_stats(v, mu, rstd);
#pragma unroll
    for (int i = 0; i < 4; ++i) {
      const f32x4 s1 = *(const f32x4*)(sc + i * 256 + lane * 4);
      const f32x4 s0 = *(const f32x4*)(sh + i * 256 + lane * 4);
      float h[4];
#pragma unroll
      for (int j = 0; j < 4; ++j) h[j] = (v[i * 4 + j] - mu) * rstd * (1.f + s1[j]) + s0[j];
      st4bf(hout + i * 256 + lane * 4, h[0], h[1], h[2], h[3]);
    }
  }
}
DEVI int rr_of(int r) { return r >= ROWS ? r - ROWS : r; }
DEVI int bi_of(int r) { return r >= ROWS ? 1 : 0; }
DEVI const float* modvec(const Params& p, int l, int ps, int r, int which) {
  const float* modv = (const float*)(p.ws + OFF_MODV);
  const int j = (rr_of(r) < SEQ) ? (ps * NBP + bi_of(r)) : 8;
  return modv + ((long)l * 9 + j) * 6144 + which * 1024;
}
DEVI const float* inrow(const Params& p, int ps, int r) {
  const int b = ps * NBP + bi_of(r), rr = rr_of(r);
  return (rr < SEQ) ? (p.x + ((long)b * SEQ + rr) * 1024) : (p.ctx + ((long)b * CTXL + (rr - SEQ)) * 1024);
}
DEVI float* xrow(const Params& p, int ps, int r) {
  const int b = ps * NBP + bi_of(r), rr = rr_of(r);
  return (rr < SEQ) ? (p.out + ((long)b * SEQ + rr) * 1024) : ((float*)(p.ws + OFF_XC) + (long)(bi_of(r) * CTXL + rr - SEQ) * 1024);
}
DEVI int row_next(int r, int nw, bool skipctx) { while (r < RP && skipctx && rr_of(r) >= SEQ) r += nw; return r; }
DEVI void row_loop(const Params& p, int ps, int l, int kind) {
  const int gw = blockIdx.x * 8 + (otid() >> 6), nw = gridDim.x * 8;
  const bool skipctx = (kind == 1 && l == 1) || kind == 3;
  u16* Hb = (u16*)(p.ws + OFF_H);
  float v[16], vn[16];
  int r = row_next(gw, nw, skipctx);
  if (r < RP) rowload(kind == 0 ? inrow(p, ps, r) : xrow(p, ps, r), v);
  while (r < RP) {
    const int rn = row_next(r + nw, nw, skipctx);
    if (rn < RP) rowload(kind == 0 ? inrow(p, ps, rn) : xrow(p, ps, rn), vn);
    float* xr = xrow(p, ps, r);
    u16* hrow = Hb + (long)r * 1024;
    if (kind == 0)      rowproc(v, nullptr, nullptr, nullptr, hrow, modvec(p, 0, ps, r, 0), modvec(p, 0, ps, r, 1));
    else if (kind == 1) rowproc(v, xr, p.ln1_g + l * 1024, p.ln1_b + l * 1024, hrow, modvec(p, l, ps, r, 3), modvec(p, l, ps, r, 4));
    else if (kind == 2) rowproc(v, xr, p.ln2_g, p.ln2_b, hrow, modvec(p, 1, ps, r, 0), modvec(p, 1, ps, r, 1));
    else                rowproc(v, xr, p.ln2_g + 1024, p.ln2_b + 1024, nullptr, nullptr, nullptr);
#pragma unroll
    for (int i = 0; i < 16; ++i) v[i] = vn[i];
    r = rn;
  }
}
DEVI void phase_mod1_l0(const Params& p, int ps) { row_loop(p, ps, 0, 0); }
DEVI void phase_rows_a(const Params& p, int ps, int l) { row_loop(p, ps, l, 1); }
DEVI void phase_rows_b(const Params& p, int ps, int l) {
  if (l == 0) row_loop(p, ps, 0, 2);
  else { row_loop(p, ps, 1, 3); if (ps + 1 < NPASS) row_loop(p, ps + 1, 0, 0); }
}
DEVI int tile_m0(int tm, int l, int TR) { const int tpb = (l == 0 ? ROWS : SEQ) / TR; return (tm / tpb) * ROWS + (tm % tpb) * TR; }
DEVI int tile_ntm(int l, int TR) { return NBP * ((l == 0 ? ROWS : SEQ) / TR); }

template <int NCOLS> DEVI void wave_tile_store(const char* wl, u16* gbase, long ld, int lane) {
  constexpr int RS = NCOLS * 2 + 16, CPR = NCOLS / 8, RPI = 64 / CPR;
  const int rsub = lane / CPR, chk = lane % CPR;
  SBAR();
#pragma unroll 4
  for (int it = 0; it < 64 / RPI; ++it) {
    const int row = it * RPI + rsub;
    const u32x4 v = *(const u32x4*)(wl + row * RS + chk * 16);
    *(u32x4*)(gbase + (long)row * ld + chk * 8) = v;
  }
}
DEVI void lds_put4(char* wl, int RS, int row, int col, float a, float b, float c, float d) { u32x2 w = {cvtpk(a, b), cvtpk(c, d)}; *(u32x2*)(wl + row * RS + col * 2) = w; }

DEVI void phase_gemm_in(const Params& p, int l, char* lds) {
  const u16* H = (const u16*)(p.ws + OFF_H);
  const u16* W = (const u16*)(p.ws + OFF_WIN) + (long)l * NF * 1024;
  u16* feat = (u16*)(p.ws + OFF_FEAT);
  const float* rope = (const float*)(p.ws + OFF_ROPE);
  const int lane = otid() & 63, wid = otid() >> 6, r32 = lane & 31, hi = lane >> 5, wm = wid & 3, wn = wid >> 2;
  constexpr int NTN = NF / 256, NTM = RP / 256;
  for (int tile = vblock(); tile < NTN * NTM; tile += gridDim.x) {
    int tm, tn; tile_map(tile, NTM, NTN, tm, tn);
    const int m0 = tm * 256, n0 = tn * 256;
    f32x16 acc[4][2];
    __syncthreads();
    gemm_kloop<2, 2>(acc, H + (long)m0 * 1024, 1024, W + (long)n0 * 1024, 1024, 1024, lds);
    SBAR();
    char* wl = lds + wid * (64 * 272);
#pragma unroll
    for (int cg2 = 0; cg2 < 2; ++cg2) {
      SBAR();
      const int cb = n0 + wn * 128 + cg2 * 64;
      int mode = 0;
      if (cb < F_GK) mode = 1;
      else if ((cb >= F_DQ && cb < F_DV) || cb == F_KR) mode = 2;
      else if (cb >= F_GATE && cb < F_KR) mode = 3;
#pragma unroll
      for (int mi = 0; mi < 2; ++mi) {
        const int m = m0 + wm * 64 + mi * 32 + r32;
#pragma unroll
        for (int q = 0; q < 4; ++q) {
          const int ci = q * 8 + hi * 4;
          float x1[4], x2[4];
#pragma unroll
          for (int j = 0; j < 4; ++j) { x1[j] = acc[2 * cg2][mi][q * 4 + j]; x2[j] = acc[2 * cg2 + 1][mi][q * 4 + j]; }
          if (mode == 1) {
#pragma unroll
            for (int j = 0; j < 4; ++j) { x1[j] *= 0.08838834764831845f; x2[j] *= 0.08838834764831845f; }
          } else if (mode == 2) {
            if (rr_of(m) < SEQ) {
              const f32x4 cs = *(const f32x4*)(rope + (long)rr_of(m) * 64 + ci);
              const f32x4 sn = *(const f32x4*)(rope + (long)rr_of(m) * 64 + 32 + ci);
#pragma unroll
              for (int j = 0; j < 4; ++j) { const float a = x1[j], bb = x2[j]; x1[j] = a * cs[j] - bb * sn[j]; x2[j] = a * sn[j] + bb * cs[j]; }
            }
          } else if (mode == 3) {
#pragma unroll
            for (int j = 0; j < 4; ++j) { x1[j] = sigmf(x1[j]); x2[j] = sigmf(x2[j]); }
          }
          lds_put4(wl, 272, mi * 32 + r32, cg2 * 64 + ci, x1[0], x1[1], x1[2], x1[3]);
          lds_put4(wl, 272, mi * 32 + r32, cg2 * 64 + 32 + ci, x2[0], x2[1], x2[2], x2[3]);
        }
      }
    }
    wave_tile_store<128>(wl, feat + (long)(m0 + wm * 64) * NF + n0 + wn * 128, NF, lane);
  }
}

DEVI void phase_gemm_up(const Params& p, int l, char* lds) {
  const u16* feat = (const u16*)(p.ws + OFF_FEAT);
  const float* rope = (const float*)(p.ws + OFF_ROPE);
  float* rs = (float*)(lds + 98304);
  const int tid = otid(), lane = tid & 63, wid = tid >> 6, r32 = lane & 31, hi = lane >> 5, wm = wid & 3, wn = wid >> 2;
  constexpr int NTM = RP / 256, NQ = 12, NK = 16;
  for (int tile = vblock(); tile < NTM * (NQ + NK); tile += gridDim.x) {
    int tm, tn; tile_map(tile, NTM, NQ + NK, tm, tn);
    const bool isq = tn < NQ;
    const int m0 = tm * 256, n0 = (isq ? tn : tn - NQ) * 128;
    const int K = isq ? 256 : 128;
    const u16* A = feat + (long)m0 * NF + (isq ? F_MQ : F_MKV);
    const u16* W = isq ? ((const u16*)(p.ws + OFF_WUQ) + (long)l * 1536 * 256 + (long)n0 * 256)
                       : ((const u16*)(p.ws + OFF_WUKV) + (long)l * 2048 * 128 + (long)n0 * 128);
    __syncthreads();
    {
      const int row = tid >> 1, half = tid & 1, n8 = K / 16;
      const u16* ap = A + (long)row * NF + half * (K / 2);
      float ss = 0.f;
      for (int i = 0; i < n8; ++i) {
        const u32x4 w = *(const u32x4*)(ap + i * 8);
#pragma unroll
        for (int j = 0; j < 4; ++j) { const float a = bflo(w[j]), b = bfhi(w[j]); ss += a * a + b * b; }
      }
      ss += __shfl_xor(ss, 1);
      if (half == 0) rs[row] = rsqrtf(ss / (float)K + EPS);
    }
    f32x16 acc[2][2];
    gemm_kloop<2, 1>(acc, A, NF, W, K, K, lds);
    const int cb = n0 + wn * 64;
    const bool dorope = isq && ((cb % 192) == 128);
    u16* outp = isq ? (u16*)(p.ws + OFF_QM) : (u16*)(p.ws + OFF_KV);
    const int ldo = isq ? 1536 : 2048;
    char* wl = lds + wid * (64 * 144);
#pragma unroll
    for (int mi = 0; mi < 2; ++mi) {
      const int ml = wm * 64 + mi * 32 + r32, m = m0 + ml;
      const float sc = rs[ml];
#pragma unroll
      for (int q = 0; q < 4; ++q) {
        const int ci = q * 8 + hi * 4;
        float x1[4], x2[4];
#pragma unroll
        for (int j = 0; j < 4; ++j) { x1[j] = acc[0][mi][q * 4 + j] * sc; x2[j] = acc[1][mi][q * 4 + j] * sc; }
        if (dorope && rr_of(m) < SEQ) {
          const f32x4 cs = *(const f32x4*)(rope + (long)rr_of(m) * 64 + ci);
          const f32x4 sn = *(const f32x4*)(rope + (long)rr_of(m) * 64 + 32 + ci);
#pragma unroll
          for (int j = 0; j < 4; ++j) { const float a = x1[j], bb = x2[j]; x1[j] = a * cs[j] - bb * sn[j]; x2[j] = a * sn[j] + bb * cs[j]; }
        }
        lds_put4(wl, 144, mi * 32 + r32, ci, x1[0], x1[1], x1[2], x1[3]);
        lds_put4(wl, 144, mi * 32 + r32, 32 + ci, x2[0], x2[1], x2[2], x2[3]);
      }
    }
    wave_tile_store<64>(wl, outp + (long)(m0 + wm * 64) * ldo + cb, ldo, lane);
  }
}

DEVI void phase_gemm_br(const Params& p, int l, char* lds) {
  const u16* feat = (const u16*)(p.ws + OFF_FEAT);
  u16* Y = (u16*)(p.ws + OFF_Y);
  const int lane = otid() & 63, wid = otid() >> 6, r32 = lane & 31, hi = lane >> 5, wm = wid & 3, wn = wid >> 2;
  const int NTM = tile_ntm(l, 128);
  for (int tile = vblock(); tile < NTM * 8; tile += gridDim.x) {
    int tm, tn; tile_map(tile, NTM, 8, tm, tn);
    const int m0 = tile_m0(tm, l, 128), n0 = tn * 128;
    const int m = m0 + wm * 32 + r32;
    f32x16 tot[2];
#pragma unroll
    for (int i = 0; i < 3; ++i) {
      const u16* A = (const u16*)(p.ws + (i == 0 ? OFF_YA : (i == 1 ? OFF_YB : OFF_YC))) + (long)m0 * 1024;
      const u16* W = (const u16*)(p.ws + OFF_WBR) + ((long)(l * 3 + i) * 1024 + n0) * 1024;
      u32x2 gt[8];
#pragma unroll
      for (int ni = 0; ni < 2; ++ni)
#pragma unroll
        for (int q = 0; q < 4; ++q)
          gt[ni * 4 + q] = *(const u32x2*)(feat + (long)m * NF + F_GATE + i * 1024 + n0 + wn * 64 + ni * 32 + q * 8 + hi * 4);
      SBAR();
      f32x16 acc[2][1];
      gemm_kloop<1, 1>(acc, A, 1024, W, 1024, 1024, lds);
      SBAR();
#pragma unroll
      for (int ni = 0; ni < 2; ++ni)
#pragma unroll
        for (int q = 0; q < 4; ++q) {
          const u32x2 g = gt[ni * 4 + q];
          const float g0 = bflo(g[0]), g1 = bfhi(g[0]), g2 = bflo(g[1]), g3 = bfhi(g[1]);
          if (i == 0) {
            tot[ni][q * 4 + 0] = g0 * acc[ni][0][q * 4 + 0]; tot[ni][q * 4 + 1] = g1 * acc[ni][0][q * 4 + 1];
            tot[ni][q * 4 + 2] = g2 * acc[ni][0][q * 4 + 2]; tot[ni][q * 4 + 3] = g3 * acc[ni][0][q * 4 + 3];
          } else {
            tot[ni][q * 4 + 0] += g0 * acc[ni][0][q * 4 + 0]; tot[ni][q * 4 + 1] += g1 * acc[ni][0][q * 4 + 1];
            tot[ni][q * 4 + 2] += g2 * acc[ni][0][q * 4 + 2]; tot[ni][q * 4 + 3] += g3 * acc[ni][0][q * 4 + 3];
          }
        }
    }
#pragma unroll
    for (int ni = 0; ni < 2; ++ni)
#pragma unroll
      for (int q = 0; q < 4; ++q) {
        const int n = n0 + wn * 64 + ni * 32 + q * 8 + hi * 4;
        st4bf(Y + (long)m * 1024 + n, tot[ni][q * 4 + 0], tot[ni][q * 4 + 1], tot[ni][q * 4 + 2], tot[ni][q * 4 + 3]);
      }
  }
}

DEVI void phase_gemm_res(const Params& p, int ps, int l, int which, char* lds) {
  const int lane = otid() & 63, wid = otid() >> 6, r32 = lane & 31, hi = lane >> 5, wm = wid & 3, wn = wid >> 2;
  const int NTM = tile_ntm(l, 128);
  const bool first = (which == 2);
  const int K = first ? 1024 : FH;
  const u16* Abase = first ? (const u16*)(p.ws + OFF_Y) : (const u16*)(p.ws + OFF_HID);
  const u16* Wbase = first ? ((const u16*)(p.ws + OFF_WOUT) + (long)l * 1024 * 1024) : ((const u16*)(p.ws + OFF_WF2) + (long)l * 1024 * FH);
  for (int tile = vblock(); tile < NTM * 8; tile += gridDim.x) {
    int tm, tn; tile_map(tile, NTM, 8, tm, tn);
    const int m0 = tile_m0(tm, l, 128), n0 = tn * 128;
    const int m = m0 + wm * 32 + r32;
    const float* gv = modvec(p, l, ps, m, which);
    float* dst = xrow(p, ps, m);
    const float* xin = dst;
    if (first && l == 0) xin = inrow(p, ps, m);
    f32x4 xi[8], g[8];
#pragma unroll
    for (int ni = 0; ni < 2; ++ni)
#pragma unroll
      for (int q = 0; q < 4; ++q) {
        const int n = n0 + wn * 64 + ni * 32 + q * 8 + hi * 4;
        xi[ni * 4 + q] = *(const f32x4*)(xin + n);
        g[ni * 4 + q] = *(const f32x4*)(gv + n);
      }
    SBAR();
    f32x16 acc[2][1];
    gemm_kloop<1, 1>(acc, Abase + (long)m0 * K, K, Wbase + (long)n0 * K, K, K, lds);
    SBAR();
#pragma unroll
    for (int ni = 0; ni < 2; ++ni)
#pragma unroll
      for (int q = 0; q < 4; ++q) {
        const int n = n0 + wn * 64 + ni * 32 + q * 8 + hi * 4;
        f32x4 o;
#pragma unroll
        for (int j = 0; j < 4; ++j) o[j] = ALPHA * xi[ni * 4 + q][j] + g[ni * 4 + q][j] * acc[ni][0][q * 4 + j];
        *(f32x4*)(dst + n) = o;
      }
  }
}

DEVI void phase_gemm_f1(const Params& p, int l, char* lds) {
  const u16* H = (const u16*)(p.ws + OFF_H);
  const u16* W = (const u16*)(p.ws + OFF_WF1) + (long)l * 5632 * 1024;
  u16* hid = (u16*)(p.ws + OFF_HID);
  const int lane = otid() & 63, wid = otid() >> 6, r32 = lane & 31, hi = lane >> 5, wm = wid & 3, wn = wid >> 2;
  const int NTM = tile_ntm(l, 256);
  for (int tile = vblock(); tile < NTM * 22; tile += gridDim.x) {
    int tm, tn; tile_map(tile, NTM, 22, tm, tn);
    const int m0 = tile_m0(tm, l, 256), n0 = tn * 256;
    f32x16 acc[4][2];
    __syncthreads();
    gemm_kloop<2, 2>(acc, H + (long)m0 * 1024, 1024, W + (long)n0 * 1024, 1024, 1024, lds);
    char* wl = lds + wid * (64 * 144);
#pragma unroll
    for (int cg2 = 0; cg2 < 2; ++cg2) {
#pragma unroll
      for (int mi = 0; mi < 2; ++mi) {
#pragma unroll
        for (int q = 0; q < 4; ++q) {
          float h[4];
#pragma unroll
          for (int j = 0; j < 4; ++j) h[j] = siluf(acc[2 * cg2][mi][q * 4 + j]) * acc[2 * cg2 + 1][mi][q * 4 + j];
          lds_put4(wl, 144, mi * 32 + r32, cg2 * 32 + q * 8 + hi * 4, h[0], h[1], h[2], h[3]);
        }
      }
    }
    wave_tile_store<64>(wl, hid + (long)(m0 + wm * 64) * FH + (tn * 4 + wn * 2) * 32, FH, lane);
  }
}

DEVI void phase_prep(const Params& p, int l) {
  const int lane = otid() & 63;
  const int gw = blockIdx.x * 8 + (otid() >> 6), nw = gridDim.x * 8;
  const float lam_init = 0.8f - 0.6f * expf(-0.3f * (float)l);
  const float* dl = p.diff_lam + l * 256;
  const float s01 = wave_sum(dl[lane] * dl[64 + lane]), s23 = wave_sum(dl[128 + lane] * dl[192 + lane]);
  const float lam = expf(s01) - expf(s23) + lam_init;
  const u16* feat = (const u16*)(p.ws + OFF_FEAT);
  const u16* og0 = (const u16*)(p.ws + OFF_OG); const u16* og1 = og0 + (long)RP * 1024;
  const u16* od0 = (const u16*)(p.ws + OFF_OD); const u16* od1 = od0 + (long)RP * 1024;
  u16* ya = (u16*)(p.ws + OFF_YA); u16* yb = (u16*)(p.ws + OFF_YB);
  const f32x4 gg = *(const f32x4*)(p.gla_norm_g + l * 256 + lane * 4);
  const float dg0 = p.diff_norm_g[l * 128 + lane * 2] * (1.f - lam_init), dg1 = p.diff_norm_g[l * 128 + lane * 2 + 1] * (1.f - lam_init);
  for (int r = gw; r < RP; r += nw) {
    if (l == 1 && rr_of(r) >= SEQ) continue;
    u32x2 ga[4], gb[4], gr[4]; unsigned da[8], db[8];
#pragma unroll
    for (int u = 0; u < 4; ++u) {
      const long off = (long)r * 1024 + u * 256 + lane * 4;
      ga[u] = *(const u32x2*)(og0 + off); gb[u] = *(const u32x2*)(og1 + off);
      gr[u] = *(const u32x2*)(feat + (long)r * NF + F_GR + u * 256 + lane * 4);
    }
#pragma unroll
    for (int h = 0; h < 8; ++h) {
      const long off = (long)r * 1024 + h * 128 + lane * 2;
      da[h] = *(const unsigned*)(od0 + off); db[h] = *(const unsigned*)(od1 + off);
    }
    float o[4][4], ss[4], e0[8], e1[8], sd[8];
#pragma unroll
    for (int u = 0; u < 4; ++u) {
      o[u][0] = bflo(ga[u][0]) + bflo(gb[u][0]); o[u][1] = bfhi(ga[u][0]) + bfhi(gb[u][0]);
      o[u][2] = bflo(ga[u][1]) + bflo(gb[u][1]); o[u][3] = bfhi(ga[u][1]) + bfhi(gb[u][1]);
      ss[u] = o[u][0] * o[u][0] + o[u][1] * o[u][1] + o[u][2] * o[u][2] + o[u][3] * o[u][3];
    }
#pragma unroll
    for (int h = 0; h < 8; ++h) {
      e0[h] = bflo(da[h]) - lam * bflo(db[h]); e1[h] = bfhi(da[h]) - lam * bfhi(db[h]);
      sd[h] = e0[h] * e0[h] + e1[h] * e1[h];
    }
#pragma unroll
    for (int m = 32; m >= 1; m >>= 1) {
#pragma unroll
      for (int u = 0; u < 4; ++u) ss[u] += __shfl_xor(ss[u], m);
#pragma unroll
      for (int h = 0; h < 8; ++h) sd[h] += __shfl_xor(sd[h], m);
    }
#pragma unroll
    for (int u = 0; u < 4; ++u) {
      const float rsd = rsqrtf(ss[u] * (1.f / 256.f) + EPS);
      const float rv[4] = {bflo(gr[u][0]), bfhi(gr[u][0]), bflo(gr[u][1]), bfhi(gr[u][1])};
      float y[4];
#pragma unroll
      for (int j = 0; j < 4; ++j) y[j] = o[u][j] * rsd * gg[j] * siluf(rv[j]);
      st4bf(ya + (long)r * 1024 + u * 256 + lane * 4, y[0], y[1], y[2], y[3]);
    }
#pragma unroll
    for (int h = 0; h < 8; ++h) {
      const float rsd = rsqrtf(sd[h] * (1.f / 128.f) + EPS);
      *(unsigned*)(yb + (long)r * 1024 + h * 128 + lane * 2) = cvtpk(e0[h] * rsd * dg0, e1[h] * rsd * dg1);
    }
  }
}

DEVI int v_st(int k, int c) { const int kk = (k & ~0xC) | ((k & 4) << 1) | ((k & 8) >> 1); return ((kk >> 3) * 4 + (c >> 5)) * 512 + ((kk & 7) * 32 + (c & 31)) * 2; }
DEVI int v_rd_base(int lane) { return ((lane & 3) << 3) | (((lane >> 2) & 3) << 6) | (((lane >> 4) & 1) << 5) | (((lane >> 5) & 1) << 8); }
constexpr int v_rd_off(int d0, int ks, int half) { return d0 * 512 + ks * 4096 + half * 2048; }
template <int OFF> DEVI s16x4 tr_read(int vb) {
  s16x4 r; asm volatile("ds_read_b64_tr_b16 %0, %1 offset:%2" : "=&v"(r) : "v"(vb), "i"(OFF) : "memory"); return r;
}
template <int D0> DEVI void pv_one(f32x16& od, int vb, bf16x8 pa0, bf16x8 pa1, bf16x8 pa2, bf16x8 pa3) {
  const s16x4 l0 = tr_read<v_rd_off(D0, 0, 0)>(vb), h0 = tr_read<v_rd_off(D0, 0, 1)>(vb), l1 = tr_read<v_rd_off(D0, 1, 0)>(vb), h1 = tr_read<v_rd_off(D0, 1, 1)>(vb);
  const s16x4 l2 = tr_read<v_rd_off(D0, 2, 0)>(vb), h2 = tr_read<v_rd_off(D0, 2, 1)>(vb), l3 = tr_read<v_rd_off(D0, 3, 0)>(vb), h3 = tr_read<v_rd_off(D0, 3, 1)>(vb);
  asm volatile("s_waitcnt lgkmcnt(0)" ::: "memory"); SBAR();
#define PK(L, H) (bf16x8){L[0], L[1], L[2], L[3], H[0], H[1], H[2], H[3]}
  od = __builtin_amdgcn_mfma_f32_32x32x16_bf16(pa0, PK(l0, h0), od, 0, 0, 0);
  od = __builtin_amdgcn_mfma_f32_32x32x16_bf16(pa1, PK(l1, h1), od, 0, 0, 0);
  od = __builtin_amdgcn_mfma_f32_32x32x16_bf16(pa2, PK(l2, h2), od, 0, 0, 0);
  od = __builtin_amdgcn_mfma_f32_32x32x16_bf16(pa3, PK(l3, h3), od, 0, 0, 0);
#undef PK
}
DEVI void pv_d0(f32x16* o, int vb, bf16x8 pa0, bf16x8 pa1, bf16x8 pa2, bf16x8 pa3) {
  pv_one<0>(o[0], vb, pa0, pa1, pa2, pa3); pv_one<1>(o[1], vb, pa0, pa1, pa2, pa3); pv_one<2>(o[2], vb, pa0, pa1, pa2, pa3); pv_one<3>(o[3], vb, pa0, pa1, pa2, pa3);
}
constexpr float ATT_THR = 8.f;
DEVI void partialSM(f32x16& p0, f32x16& p1, float& m_reg, float& mn, float& alpha, float scale) {
  const float C = scale * 1.4426950408889634f;
  float pmax = p0[0];
#pragma unroll
  for (int r = 1; r < 16; ++r) pmax = fmaxf(pmax, p0[r]);
#pragma unroll
  for (int r = 0; r < 16; ++r) pmax = fmaxf(pmax, p1[r]);
  { auto rr = __builtin_amdgcn_permlane32_swap(__float_as_uint(pmax), __float_as_uint(pmax), false, false);
    pmax = fmaxf(__uint_as_float(rr[0]), __uint_as_float(rr[1])); }
  if (__builtin_expect(__all(pmax - m_reg <= ATT_THR / scale), 1)) { mn = m_reg; alpha = 1.f; }
  else { mn = fmaxf(m_reg, pmax); alpha = __builtin_amdgcn_exp2f((m_reg - mn) * C); m_reg = mn; }
  const float mnC = -mn * C;
#pragma unroll
  for (int r = 0; r < 16; ++r) p0[r] = fmaf(p0[r], C, mnC);
#pragma unroll
  for (int r = 0; r < 16; ++r) p1[r] = fmaf(p1[r], C, mnC);
#pragma unroll
  for (int r = 0; r < 16; ++r) p0[r] = __builtin_amdgcn_exp2f(p0[r]);
}
#define PK4(P, BASE, OUT) do { unsigned a0 = cvtpk(P[BASE + 0], P[BASE + 1]), a1 = cvtpk(P[BASE + 2], P[BASE + 3]);   \
    unsigned b0 = cvtpk(P[BASE + 4], P[BASE + 5]), b1 = cvtpk(P[BASE + 6], P[BASE + 7]);                              \
    auto r0 = __builtin_amdgcn_permlane32_swap(a0, b0, false, false); auto r1 = __builtin_amdgcn_permlane32_swap(a1, b1, false, false); \
    u32x4 w = {r0[0], r1[0], r0[1], r1[1]}; OUT = *reinterpret_cast<bf16x8*>(&w); } while (0)
DEVI void finishSM(f32x16& p0, f32x16& p1, float alpha, float& l_reg, bf16x8& pa0, bf16x8& pa1, bf16x8& pa2, bf16x8& pa3) {
#pragma unroll
  for (int r = 0; r < 16; ++r) p1[r] = __builtin_amdgcn_exp2f(p1[r]);
  float ps = 0;
#pragma unroll
  for (int r = 0; r < 16; ++r) ps += p0[r];
#pragma unroll
  for (int r = 0; r < 16; ++r) ps += p1[r];
  { auto rr = __builtin_amdgcn_permlane32_swap(__float_as_uint(ps), __float_as_uint(ps), false, false);
    ps = __uint_as_float(rr[0]) + __uint_as_float(rr[1]); }
  l_reg = l_reg * alpha + ps;
  PK4(p0, 0, pa0); PK4(p0, 8, pa1); PK4(p1, 0, pa2); PK4(p1, 8, pa3);
}

template <int DQK, bool PIPE>
DEVI void attn_body(const u16* __restrict__ Qb, int ldq, const u16* __restrict__ K0, int ldk0, const u16* __restrict__ K1, int ldk1,
                    const u16* __restrict__ Vh, int ldv, u16* __restrict__ Ob, int ldo, int seq, float scale, char* lds) {
  constexpr int KRB = DQK * 2, SHM_K = 64 * KRB, SHM_V = 16384, ND0 = DQK / 16, NCH = DQK / 8, NKC = (64 * NCH) / NTHREADS;
  const int tid = otid(), wid = tid >> 6, lane = tid & 63, r32 = lane & 31, hi = lane >> 5;
  char* V_lds = lds; char* K_lds = lds + 2 * SHM_V;
  float* wsf = (float*)(lds + 2 * SHM_V + 2 * SHM_K) + wid * 64; float* li_l = wsf; float* al_l = wsf + 32;
  float m_reg = -1e30f, l_reg = 0; f32x16 o[4];
#pragma unroll
  for (int d = 0; d < 4; ++d)
#pragma unroll
    for (int r = 0; r < 16; ++r) o[d][r] = 0.f;
  bf16x8 qr[ND0];
  const u16* Qw = Qb + (long)(wid * 32 + r32) * ldq + hi * 8;
#pragma unroll
  for (int d0 = 0; d0 < ND0; ++d0) qr[d0] = *(const bf16x8*)(Qw + d0 * 16);
  const int sr = tid >> 4, sc = (tid & 15) * 8, vst0 = v_st(sr, sc), vst1 = v_st(32 + sr, sc);
  const int vb0 = (int)(uintptr_t)V_lds + v_rd_base(lane);
  bf16x8 vs0, vs1, ksg[NKC];
  const int krow0 = (DQK == 64) ? (tid >> 3) : (tid >> 4), kchk0 = (DQK == 64) ? (tid & 7) : (tid & 15);
  const u16* kp0 = K0 + (long)krow0 * ldk0 + kchk0 * 8;
  const int koff0 = krow0 * KRB + ((kchk0 * 16) ^ (((krow0 >> 1) & 7) << 4));
  const int koff1 = (krow0 + 32) * KRB + ((kchk0 * 16) ^ (((krow0 >> 1) & 7) << 4));
  const int krow2 = tid >> 3, kchk2 = 16 + (tid & 7);
  const u16* kp2 = K1 + (long)krow2 * ldk1 + (tid & 7) * 8;
  const int koff2 = krow2 * KRB + ((kchk2 * 16) ^ (((krow2 >> 1) & 7) << 4));
  const u16* vp0 = Vh + (long)sr * ldv + sc;
#define SLOAD(k0) do { vs0 = *(const bf16x8*)(vp0 + (long)(k0) * ldv); vs1 = *(const bf16x8*)(vp0 + (long)((k0) + 32) * ldv); \
    ksg[0] = *(const bf16x8*)(kp0 + (long)(k0) * ldk0); \
    if constexpr (DQK == 192) { ksg[1] = *(const bf16x8*)(kp0 + (long)((k0) + 32) * ldk0); ksg[2] = *(const bf16x8*)(kp2 + (long)(k0) * ldk1); } } while (0)
#define SWRITE(b) do { *(bf16x8*)(V_lds + (b) * SHM_V + vst0) = vs0; *(bf16x8*)(V_lds + (b) * SHM_V + vst1) = vs1; \
    *(bf16x8*)(K_lds + (b) * SHM_K + koff0) = ksg[0]; \
    if constexpr (DQK == 192) { *(bf16x8*)(K_lds + (b) * SHM_K + koff1) = ksg[1]; *(bf16x8*)(K_lds + (b) * SHM_K + koff2) = ksg[2]; } } while (0)
#define SWAIT() asm volatile("s_waitcnt vmcnt(0)" ::: "memory")
#define RESC(a) do { if (__any((a) < 1.f)) { if (hi == 0) al_l[r32] = (a); asm volatile("s_waitcnt lgkmcnt(0)" ::: "memory"); \
    _Pragma("unroll") for (int d = 0; d < 4; ++d) _Pragma("unroll") for (int r = 0; r < 16; ++r) o[d][r] *= al_l[crow(r, hi)]; } } while (0)
#define QKT(P0, P1, KB) do { _Pragma("unroll") for (int r_ = 0; r_ < 16; ++r_) { P0[r_] = 0.f; P1[r_] = 0.f; } \
    _Pragma("unroll") for (int d0 = 0; d0 < ND0; ++d0) { const int cb_ = (d0 * 16 + hi * 8) * 2; \
      bf16x8 b0_ = *(const bf16x8*)((KB) + r32 * KRB + (cb_ ^ (((r32 >> 1) & 7) << 4))); \
      bf16x8 b1_ = *(const bf16x8*)((KB) + (32 + r32) * KRB + (cb_ ^ (((r32 >> 1) & 7) << 4))); \
      P0 = __builtin_amdgcn_mfma_f32_32x32x16_bf16(b0_, qr[d0], P0, 0, 0, 0); \
      P1 = __builtin_amdgcn_mfma_f32_32x32x16_bf16(b1_, qr[d0], P1, 0, 0, 0); } } while (0)
  bf16x8 pa0, pa1, pa2, pa3; const int NT = seq / 64;
  if constexpr (PIPE) {
    f32x16 pA0, pA1, pB0, pB1; float mnA, mnB, alA, alB;
    SLOAD(0); SWAIT(); SWRITE(0); __syncthreads();
    QKT(pA0, pA1, K_lds); partialSM(pA0, pA1, m_reg, mnA, alA, scale);
    SLOAD(64);
    SWAIT(); SWRITE(1); __syncthreads();
    for (int j = 1; j + 1 < NT; j += 2) {
      SBAR(); QKT(pB0, pB1, K_lds + SHM_K);
      finishSM(pA0, pA1, alA, l_reg, pa0, pa1, pa2, pa3); SBAR();
      SLOAD((j + 1) * 64); SBAR();
      pv_d0(o, vb0, pa0, pa1, pa2, pa3); partialSM(pB0, pB1, m_reg, mnB, alB, scale);
      __syncthreads(); SWAIT(); SWRITE(0);
      RESC(alB); __syncthreads();
      SBAR(); QKT(pA0, pA1, K_lds);
      finishSM(pB0, pB1, alB, l_reg, pa0, pa1, pa2, pa3); SBAR();
      SLOAD((j + 2) * 64); SBAR();
      pv_d0(o, vb0 + SHM_V, pa0, pa1, pa2, pa3); partialSM(pA0, pA1, m_reg, mnA, alA, scale);
      __syncthreads(); SWAIT(); SWRITE(1);
      RESC(alA); __syncthreads();
    }
    SBAR(); QKT(pB0, pB1, K_lds + SHM_K);
    finishSM(pA0, pA1, alA, l_reg, pa0, pa1, pa2, pa3); SBAR();
    pv_d0(o, vb0, pa0, pa1, pa2, pa3); partialSM(pB0, pB1, m_reg, mnB, alB, scale);
    __syncthreads(); RESC(alB);
    finishSM(pB0, pB1, alB, l_reg, pa0, pa1, pa2, pa3); SBAR();
    pv_d0(o, vb0 + SHM_V, pa0, pa1, pa2, pa3);
  } else {
    f32x16 p0, p1; float mn, al;
    SLOAD(0); SWAIT(); SWRITE(0); __syncthreads();
    for (int j = 0; j < NT; ++j) {
      const int bsel = j & 1;
      if (j + 1 < NT) SLOAD((j + 1) * 64);
      SBAR(); QKT(p0, p1, K_lds + bsel * SHM_K);
      partialSM(p0, p1, m_reg, mn, al, scale);
      RESC(al);
      finishSM(p0, p1, al, l_reg, pa0, pa1, pa2, pa3); SBAR();
      pv_d0(o, vb0 + bsel * SHM_V, pa0, pa1, pa2, pa3);
      if (j + 1 < NT) { SWAIT(); SWRITE(bsel ^ 1); }
      __syncthreads();
    }
  }
  if (hi == 0) li_l[r32] = l_reg; asm volatile("s_waitcnt lgkmcnt(0)" ::: "memory");
  float rli[16];
#pragma unroll
  for (int r = 0; r < 16; ++r) rli[r] = __builtin_amdgcn_rcpf(li_l[crow(r, hi)]);
  u16* Ow = Ob + (long)(wid * 32) * ldo;
#pragma unroll
  for (int r = 0; r < 16; ++r) { const int orow = crow(r, hi);
#pragma unroll
    for (int d0 = 0; d0 < 4; ++d0) Ow[(long)orow * ldo + d0 * 32 + r32] = f2bf(o[d0][r] * rli[r]); }
  __syncthreads();
#undef SLOAD
#undef SWRITE
#undef SWAIT
#undef RESC
#undef QKT
}

DEVI long gla_row(int bi, int dir, int cc, int i) {
  const int L = (cc < 4) ? CTXL : SEQ, c = (cc < 4) ? cc : cc - 4, rb = bi * ROWS + ((cc < 4) ? SEQ : 0);
  const int tl = c * 64 + i;
  return (long)(rb + (dir ? (L - 1 - tl) : tl));
}
DEVI void gla_seq(const Params& p, int l, int item, char* lds) {
  const int tid = otid(), wid = tid >> 6, lane = tid & 63, r32 = lane & 31, hi = lane >> 5;
  const int bi = item >> 5, h = (item >> 3) & 3, dir = (item >> 2) & 1, sl = item & 3;
  char* qs = lds;
  char* ks = lds + 16384;
  char* kT = lds + 32768;
  char* vT = lds + 32768 + 18432;
  char* sT = lds + 32768 + 18432 + 9216;
  float* gas = (float*)(sT + 32768);
  float* segtot = gas + 1024;
  float* ebl = segtot + 512;
  const u16* feat = (const u16*)(p.ws + OFF_FEAT);
  u16* og = (u16*)(p.ws + OFF_OG) + (long)dir * RP * 1024;
  const int d = tid & 127, seg = tid >> 7;
  float w2[16];
#pragma unroll
  for (int r = 0; r < 16; ++r) w2[r] = p.gla_w_a2[(((long)l * 2 + dir) * 16 + r) * 512 + h * 128 + d];
  const float ba = p.gla_b_a[((long)l * 2 + dir) * 512 + h * 128 + d];
  __syncthreads();
  for (int i = tid; i < 8192; i += NTHREADS) ((unsigned*)sT)[i] = 0u;
  f32x16 Sacc;
#pragma unroll
  for (int r = 0; r < 16; ++r) Sacc[r] = 0.f;
  const int dblk = wid >> 1, eblk = wid & 1, iblk = (wid >> 1) & 1;
  u32x4 pq0, pq1, pk0, pk1, pv; u16 pg0, pg1;
  const int row0 = tid >> 4, chq = tid & 15;
  const int vi0 = tid >> 3, ve8 = (tid & 7) * 8;
  const int g0i = (tid * 2) >> 4, g0r = (tid * 2) & 15;
#define GLOADC(cc_) do { \
    const u16* f0_ = feat + gla_row(bi, dir, (cc_), row0) * NF + h * 128 + chq * 8; \
    const u16* f1_ = feat + gla_row(bi, dir, (cc_), 32 + row0) * NF + h * 128 + chq * 8; \
    pq0 = *(const u32x4*)(f0_ + F_GQ); pk0 = *(const u32x4*)(f0_ + F_GK); pq1 = *(const u32x4*)(f1_ + F_GQ); pk1 = *(const u32x4*)(f1_ + F_GK); \
    pv = *(const u32x4*)(feat + gla_row(bi, dir, (cc_), vi0) * NF + F_GV + h * 256 + sl * 64 + ve8); \
    const u16* g_ = feat + gla_row(bi, dir, (cc_), g0i) * NF + F_GA + dir * 16 + g0r; pg0 = g_[0]; pg1 = g_[1]; } while (0)
  GLOADC(0);
  int cur = 0;
  for (int cc = 0; cc < 132; ++cc) {
    {
      const int so0 = row0 * 256 + ((chq ^ (row0 & 7)) << 4), so1 = so0 + 32 * 256;
      *(u32x4*)(qs + so0) = pq0; *(u32x4*)(ks + so0) = pk0; *(u32x4*)(qs + so1) = pq1; *(u32x4*)(ks + so1) = pk1;
#pragma unroll
      for (int j = 0; j < 4; ++j) {
        *(u16*)(vT + (ve8 + 2 * j) * 144 + vi0 * 2) = (u16)(pv[j] & 0xffffu);
        *(u16*)(vT + (ve8 + 2 * j + 1) * 144 + vi0 * 2) = (u16)(pv[j] >> 16);
      }
      gas[tid * 2] = bf2f(pg0); gas[tid * 2 + 1] = bf2f(pg1);
    }
    __syncthreads();
    if (cc + 1 < 132) GLOADC(cc + 1);
    SBAR();
    float bcum[16];
    {
      float run = 0.f;
#pragma unroll
      for (int ii = 0; ii < 16; ++ii) {
        const float* gr_ = gas + (seg * 16 + ii) * 16;
        float z = ba;
#pragma unroll
        for (int r = 0; r < 16; ++r) z += gr_[r] * w2[r];
        const float ls = fminf(z, 0.f) - __logf(1.f + __expf(-fabsf(z)));
        run += ls * (1.f / 16.f);
        bcum[ii] = run;
      }
      segtot[seg * 128 + d] = run;
    }
    __syncthreads();
    {
      float pre = 0.f, tot = 0.f;
#pragma unroll
      for (int s_ = 0; s_ < 4; ++s_) { const float v = segtot[s_ * 128 + d]; tot += v; if (s_ < seg) pre += v; }
      const float etot = __expf(tot);
      if (seg == 0) ebl[d] = etot;
#pragma unroll
      for (int ii = 0; ii < 16; ++ii) {
        const int i = seg * 16 + ii;
        const float bb = bcum[ii] + pre;
        const int so = i * 256 + (((d >> 3) ^ (i & 7)) << 4) + (d & 7) * 2;
        const float q = bf2f(*(const u16*)(qs + so)), k = bf2f(*(const u16*)(ks + so));
        const float eb = __expf(bb), ieb = __frcp_rn(eb);
        *(u16*)(qs + so) = f2bf(q * eb);
        *(u16*)(ks + so) = f2bf(k * ieb);
        *(u16*)(kT + d * 144 + i * 2) = f2bf(k * (etot * ieb));
      }
    }
    __syncthreads();
    const char* sTc = sT + cur * 16384; char* sTn = sT + (cur ^ 1) * 16384;
    if (wid < 4) {
      f32x16 p0, p1, o;
#pragma unroll
      for (int r = 0; r < 16; ++r) { p0[r] = 0.f; p1[r] = 0.f; o[r] = 0.f; }
      const int irow = iblk * 32 + r32;
#pragma unroll
      for (int d0 = 0; d0 < 8; ++d0) {
        const int chn = d0 * 2 + hi;
        const bf16x8 b0 = *(const bf16x8*)(ks + r32 * 256 + ((chn ^ (r32 & 7)) << 4));
        const bf16x8 b1 = *(const bf16x8*)(ks + (32 + r32) * 256 + ((chn ^ (r32 & 7)) << 4));
        const bf16x8 qf = *(const bf16x8*)(qs + irow * 256 + ((chn ^ (irow & 7)) << 4));
        p0 = __builtin_amdgcn_mfma_f32_32x32x16_bf16(b0, qf, p0, 0, 0, 0);
        p1 = __builtin_amdgcn_mfma_f32_32x32x16_bf16(b1, qf, p1, 0, 0, 0);
      }
#pragma unroll
      for (int r = 0; r < 16; ++r) {
        const int j0 = crow(r, hi), j1 = 32 + j0;
        const bool k0 = dir ? (j0 < irow) : (j0 <= irow), k1 = dir ? (j1 < irow) : (j1 <= irow);
        p0[r] = k0 ? p0[r] : 0.f; p1[r] = k1 ? p1[r] : 0.f;
      }
      bf16x8 pa0, pa1, pa2, pa3;
      PK4(p0, 0, pa0); PK4(p0, 8, pa1); PK4(p1, 0, pa2); PK4(p1, 8, pa3);
      const char* vrow = vT + (eblk * 32 + r32) * 144 + hi * 16;
      o = __builtin_amdgcn_mfma_f32_32x32x16_bf16(pa0, *(const bf16x8*)(vrow), o, 0, 0, 0);
      o = __builtin_amdgcn_mfma_f32_32x32x16_bf16(pa1, *(const bf16x8*)(vrow + 32), o, 0, 0, 0);
      o = __builtin_amdgcn_mfma_f32_32x32x16_bf16(pa2, *(const bf16x8*)(vrow + 64), o, 0, 0, 0);
      o = __builtin_amdgcn_mfma_f32_32x32x16_bf16(pa3, *(const bf16x8*)(vrow + 96), o, 0, 0, 0);
      const int erow = eblk * 32 + r32;
#pragma unroll
      for (int d0 = 0; d0 < 8; ++d0) {
        const int chn = d0 * 2 + hi;
        const bf16x8 qf = *(const bf16x8*)(qs + irow * 256 + ((chn ^ (irow & 7)) << 4));
        const bf16x8 sf = *(const bf16x8*)(sTc + erow * 256 + ((chn ^ (erow & 7)) << 4));
        o = __builtin_amdgcn_mfma_f32_32x32x16_bf16(qf, sf, o, 0, 0, 0);
      }
#pragma unroll
      for (int r = 0; r < 16; ++r)
        og[gla_row(bi, dir, cc, iblk * 32 + crow(r, hi)) * 1024 + h * 256 + sl * 64 + eblk * 32 + r32] = f2bf(o[r]);
    }
    {
#pragma unroll
      for (int r = 0; r < 16; ++r) Sacc[r] *= ebl[dblk * 32 + crow(r, hi)];
      const char* krow = kT + (dblk * 32 + r32) * 144 + hi * 16;
      const char* vrow = vT + (eblk * 32 + r32) * 144 + hi * 16;
#pragma unroll
      for (int k16 = 0; k16 < 4; ++k16)
        Sacc = __builtin_amdgcn_mfma_f32_32x32x16_bf16(*(const bf16x8*)(krow + k16 * 32), *(const bf16x8*)(vrow + k16 * 32), Sacc, 0, 0, 0);
      const int erow = eblk * 32 + r32;
#pragma unroll
      for (int q4 = 0; q4 < 4; ++q4) {
        const int chn = dblk * 4 + q4;
        u32x2 w = {cvtpk(Sacc[q4 * 4 + 0], Sacc[q4 * 4 + 1]), cvtpk(Sacc[q4 * 4 + 2], Sacc[q4 * 4 + 3])};
        *(u32x2*)(sTn + erow * 256 + ((chn ^ (erow & 7)) << 4) + hi * 8) = w;
      }
    }
    cur ^= 1;
    __syncthreads();
  }
#undef GLOADC
}

DEVI void phase_mix(const Params& p, int ps, int l, char* lds) {
  __shared__ int s_q;
  const u16* feat = (const u16*)(p.ws + OFF_FEAT);
  const u16* qm = (const u16*)(p.ws + OFF_QM);
  const u16* kvb = (const u16*)(p.ws + OFF_KV);
  u16* od = (u16*)(p.ws + OFF_OD);
  u16* yc = (u16*)(p.ws + OFF_YC);
  const int x = blockIdx.x & 7, jb = blockIdx.x >> 3;
  if (jb < 8) gla_seq(p, l, x * 8 + jb, lds);
  int* ctr = (int*)(p.ws + OFF_CTR) + 128 + (ps * 2 + l) * 8 + x;
  const int nmla = NBP * 32, ndiff = NBP * 64, nctx = (l == 0) ? (NBP * 24 / 8) : 0;
  for (;;) {
    __syncthreads();
    if (otid() == 0) s_q = atomicAdd(ctr, 1);
    __syncthreads();
    const int q = s_q;
    if (q >= nmla) break;
    const int bi = q >> 5, h = x, q0 = bi * ROWS + (q & 31) * 256;
    const long k0 = (long)bi * ROWS;
    attn_body<192, false>(qm + (long)q0 * 1536 + h * 192, 1536, kvb + k0 * 2048 + h * 256, 2048, feat + k0 * NF + F_KR, NF,
                          kvb + k0 * 2048 + h * 256 + 128, 2048, yc + (long)q0 * 1024 + h * 128, 1024, ROWS, 0.07216878364870322f, lds);
  }
  int* ctr2 = ctr + 128;
  for (;;) {
    __syncthreads();
    if (otid() == 0) s_q = atomicAdd(ctr2, 1);
    __syncthreads();
    const int q = s_q;
    if (q >= ndiff + nctx) break;
    if (q < ndiff) {
      const int bi = q >> 6, hm = x + 8 * ((q >> 5) & 1), h = hm >> 1, mp = hm & 1, q0 = bi * ROWS + (q & 31) * 256;
      const long k0 = (long)bi * ROWS;
      attn_body<64, true>(feat + (long)q0 * NF + F_DQ + h * 128 + mp * 64, NF, feat + k0 * NF + F_DK + h * 128 + mp * 64, NF, feat, NF,
                          feat + k0 * NF + F_DV + h * 128, NF, od + (long)mp * RP * 1024 + (long)q0 * 1024 + h * 128, 1024, ROWS, 0.125f, lds);
    } else {
      const int u = (q - ndiff) * 8 + x, bi = u / 24, v = u % 24;
      const long c0 = (long)bi * ROWS + SEQ;
      if (v < 8) {
        const int h = v;
        attn_body<192, false>(qm + c0 * 1536 + h * 192, 1536, kvb + c0 * 2048 + h * 256, 2048, feat + c0 * NF + F_KR, NF,
                              kvb + c0 * 2048 + h * 256 + 128, 2048, yc + c0 * 1024 + h * 128, 1024, CTXL, 0.07216878364870322f, lds);
      } else {
        const int h = (v - 8) >> 1, mp = (v - 8) & 1;
        attn_body<64, true>(feat + c0 * NF + F_DQ + h * 128 + mp * 64, NF, feat + c0 * NF + F_DK + h * 128 + mp * 64, NF, feat, NF,
                            feat + c0 * NF + F_DV + h * 128, NF, od + (long)mp * RP * 1024 + c0 * 1024 + h * 128, 1024, CTXL, 0.125f, lds);
      }
    }
  }
}

DEVI void grid_bar(unsigned* ctr, unsigned& epoch) {
  asm volatile("s_waitcnt vmcnt(0)" ::: "memory");
  __syncthreads();
  if (threadIdx.x == 0) {
    __builtin_amdgcn_fence(__ATOMIC_RELEASE, "agent");
    asm volatile("s_waitcnt vmcnt(0)" ::: "memory");
    __hip_atomic_fetch_add(ctr, 1u, __ATOMIC_RELAXED, __HIP_MEMORY_SCOPE_AGENT);
    const unsigned target = (epoch + 1u) * gridDim.x;
    while (__hip_atomic_load(ctr, __ATOMIC_RELAXED, __HIP_MEMORY_SCOPE_AGENT) < target) __builtin_amdgcn_s_sleep(1);
    __builtin_amdgcn_fence(__ATOMIC_ACQUIRE, "agent");
    asm volatile("s_waitcnt vmcnt(0)" ::: "memory");
  }
  __syncthreads();
  ++epoch;
}

__global__ void __launch_bounds__(NTHREADS) fwd_megakernel(Params p) {
  extern __shared__ __attribute__((aligned(16))) char lds[];
  cg::grid_group grid = cg::this_grid();
  if (blockIdx.x == 0) ((int*)(p.ws + OFF_CTR))[threadIdx.x] = 0;
  unsigned* gbar = (unsigned*)(p.ws + OFF_CTR) + 96; unsigned epoch = 0;
  for (int l = 0; l < 2; ++l) {
    conv_weight(p.w_in + (long)l * 1024 * NIN_ORIG, NIN_ORIG, (u16*)(p.ws + OFF_WIN) + (long)l * NF * 1024, NF, 1024, 1, nullptr, lds);
    conv_weight(p.mla_w_uq + (long)l * 256 * 1536, 1536, (u16*)(p.ws + OFF_WUQ) + (long)l * 1536 * 256, 1536, 256, 0, p.mla_q_norm_g + l * 256, lds);
    conv_weight(p.mla_w_ukv + (long)l * 128 * 2048, 2048, (u16*)(p.ws + OFF_WUKV) + (long)l * 2048 * 128, 2048, 128, 0, p.mla_kv_norm_g + l * 128, lds);
    for (int i = 0; i < 3; ++i)
      conv_weight(p.w_branch + ((long)l * 3 + i) * 1024 * 1024, 1024, (u16*)(p.ws + OFF_WBR) + ((long)l * 3 + i) * 1024 * 1024, 1024, 1024, 0, nullptr, lds);
    conv_weight(p.w_out + (long)l * 1024 * 1024, 1024, (u16*)(p.ws + OFF_WOUT) + (long)l * 1024 * 1024, 1024, 1024, 0, nullptr, lds);
    conv_weight(p.ffn_w_in + (long)l * 1024 * 5632, 5632, (u16*)(p.ws + OFF_WF1) + (long)l * 5632 * 1024, 5632, 1024, 2, nullptr, lds);
    conv_weight(p.ffn_w_out + (long)l * FH * 1024, 1024, (u16*)(p.ws + OFF_WF2) + (long)l * 1024 * FH, 1024, FH, 0, nullptr, lds);
  }
  phase_modv(p, lds);
  phase_rope(p);
  grid.sync();
  phase_mod1_l0(p, 0);
  grid_bar(gbar, epoch);
  for (int ps = 0; ps < NPASS; ++ps) {
    for (int l = 0; l < 2; ++l) {
      phase_gemm_in(p, l, lds);              grid_bar(gbar, epoch);
      phase_gemm_up(p, l, lds);              grid_bar(gbar, epoch);
      phase_mix(p, ps, l, lds);              grid_bar(gbar, epoch);
      phase_prep(p, l);                      grid_bar(gbar, epoch);
      phase_gemm_br(p, l, lds);              grid_bar(gbar, epoch);
      phase_gemm_res(p, ps, l, 2, lds);      grid_bar(gbar, epoch);
      phase_rows_a(p, ps, l);                grid_bar(gbar, epoch);
      phase_gemm_f1(p, l, lds);              grid_bar(gbar, epoch);
      phase_gemm_res(p, ps, l, 5, lds);      grid_bar(gbar, epoch);
      phase_rows_b(p, ps, l);                if (!(ps == NPASS - 1 && l == 1)) grid_bar(gbar, epoch);
    }
  }
}

extern "C" void kernel_launch(void* const* d_in, const int* in_sizes, int n_in, void* d_out, int out_size, void* d_ws, size_t ws_size, hipStream_t stream) {
  static int grid_blocks = 0;
  if (grid_blocks == 0) {
    if (n_in != 24 || ws_size < WS_END) { fprintf(stderr, "kernel_launch: n_in %d ws %zu need %zu\n", n_in, ws_size, (size_t)WS_END); grid_blocks = -1; return; }
    int dev = 0, cus = 0, per_cu = 0;
    hipGetDevice(&dev);
    hipDeviceGetAttribute(&cus, hipDeviceAttributeMultiprocessorCount, dev);
    if (hipFuncSetAttribute((const void*)fwd_megakernel, hipFuncAttributeMaxDynamicSharedMemorySize, LDS_BYTES) != hipSuccess) { fprintf(stderr, "kernel_launch: LDS attr failed\n"); grid_blocks = -1; return; }
    hipOccupancyMaxActiveBlocksPerMultiprocessor(&per_cu, (const void*)fwd_megakernel, NTHREADS, LDS_BYTES);
    if (per_cu < 1) { fprintf(stderr, "kernel_launch: occupancy %d\n", per_cu); per_cu = 1; }
    if (per_cu > 1) per_cu = 1;
    grid_blocks = cus * per_cu;
  }
  if (grid_blocks < 0) return;
  Params p{};
  const float** pp = (const float**)&p;
  for (int i = 0; i < 24; ++i) pp[i] = (const float*)d_in[i];
  p.out = (float*)d_out; p.ws = (char*)d_ws;
  void* args[] = {&p};
  hipError_t e = hipLaunchCooperativeKernel((const void*)fwd_megakernel, dim3(grid_blocks), dim3(NTHREADS), args, LDS_BYTES, stream);
  if (e != hipSuccess) fprintf(stderr, "cooperative launch failed: %s (grid %d)\n", hipGetErrorString(e), grid_blocks);
}
```
